# Optimizing an MI355X kernel written in HIP

```python
import math
import jax, jax.numpy as jnp
from jax import lax
import numpy as np

D_MODEL = 1024
BATCH = 16
SEQ = 2048
DEPTH = 1

PLE_DIM = 256
D_MIX = D_MODEL
D_SSM = D_MIX // 2
SSM_GROUP = 16
N_SSM_GROUPS = D_SSM // SSM_GROUP
SSM_STATE = 64
D_SGU = D_MIX - D_SSM
SGU_CHUNK = 128
N_SGU_HEADS = 4
SGU_HEAD_DIM = D_SGU // N_SGU_HEADS
D_IN = D_SSM + 2 * D_SGU
PEER_HEADS = 8
PEER_NKEYS = 128
PEER_NEXPERTS = PEER_NKEYS * PEER_NKEYS
PEER_TOPK = 16
PEER_HALF = 128
PEER_QDIM = 2 * PEER_HALF
PEER_BLOCK = 128
EPS = 1e-6

kernel_name = "hymba_s5_sgu_peer_block"


def _gelu(x):
    return jax.nn.gelu(x, approximate=False)


def _rmsnorm(x, g):
    x32 = x.astype(jnp.float32)
    y = x32 * lax.rsqrt(jnp.mean(x32 * x32, axis=-1, keepdims=True) + EPS)
    return (y * g.astype(jnp.float32)).astype(x.dtype)


def _s5(xs, a_re, a_im, log_dt, b_re, b_im, c_re, c_im, d):
    bsz, s, _ = xs.shape
    f32 = jnp.float32
    u = xs.astype(f32).reshape(bsz, s, N_SSM_GROUPS, SSM_GROUP)
    lam_re, lam_im = a_re.astype(f32), a_im.astype(f32)
    dt = jnp.exp(log_dt.astype(f32))[:, None]
    mag = jnp.exp(lam_re * dt)
    ang = lam_im * dt
    abar_re, abar_im = mag * jnp.cos(ang), mag * jnp.sin(ang)
    nr, ni = abar_re - 1.0, abar_im
    den = lam_re * lam_re + lam_im * lam_im
    coef_re = (nr * lam_re + ni * lam_im) / den
    coef_im = (ni * lam_re - nr * lam_im) / den
    br, bi = b_re.astype(f32), b_im.astype(f32)
    bbar_re = coef_re[..., None] * br - coef_im[..., None] * bi
    bbar_im = coef_re[..., None] * bi + coef_im[..., None] * br
    bu_re = jnp.einsum('bsgc,gpc->sbgp', u, bbar_re)
    bu_im = jnp.einsum('bsgc,gpc->sbgp', u, bbar_im)
    a_s_re = jnp.broadcast_to(abar_re[None, None], (s, 1, N_SSM_GROUPS, SSM_STATE))
    a_s_im = jnp.broadcast_to(abar_im[None, None], (s, 1, N_SSM_GROUPS, SSM_STATE))

    def combine(e1, e2):
        a1r, a1i, b1r, b1i = e1
        a2r, a2i, b2r, b2i = e2
        ar = a1r * a2r - a1i * a2i
        ai = a1r * a2i + a1i * a2r
        bo_r = a2r * b1r - a2i * b1i + b2r
        bo_i = a2r * b1i + a2i * b1r + b2i
        return ar, ai, bo_r, bo_i

    _, _, h_re, h_im = lax.associative_scan(combine, (a_s_re, a_s_im, bu_re, bu_im), axis=0)
    y = (jnp.einsum('sbgp,gcp->bsgc', h_re, c_re.astype(f32))
         - jnp.einsum('sbgp,gcp->bsgc', h_im, c_im.astype(f32)))
    y = y + d.astype(f32).reshape(N_SSM_GROUPS, SSM_GROUP) * u
    return y.reshape(bsz, s, D_SSM).astype(xs.dtype)


def _sgu(u, v, ln_g, ln_b, ws, bs):
    bsz, s, _ = u.shape
    nc = s // SGU_CHUNK
    u = _gelu(u)
    v = _gelu(v)
    v32 = v.astype(jnp.float32).reshape(bsz, s, N_SGU_HEADS, SGU_HEAD_DIM)
    mu = jnp.mean(v32, axis=-1, keepdims=True)
    var = jnp.mean(jnp.square(v32 - mu), axis=-1, keepdims=True)
    vn = ((v32 - mu) * lax.rsqrt(var + EPS)
          * ln_g.astype(jnp.float32).reshape(N_SGU_HEADS, SGU_HEAD_DIM)
          + ln_b.astype(jnp.float32).reshape(N_SGU_HEADS, SGU_HEAD_DIM)).astype(u.dtype)
    vc = vn.reshape(bsz, nc, SGU_CHUNK, N_SGU_HEADS, SGU_HEAD_DIM)
    causal = jnp.tril(jnp.ones((SGU_CHUNK, SGU_CHUNK), dtype=bool))
    wsm = jnp.where(causal[None], ws, jnp.zeros_like(ws))
    mixed = jnp.einsum('hts,bcshd->bcthd', wsm, vc) + bs.T[None, None, :, :, None]
    return u * mixed.reshape(bsz, s, D_SGU).astype(u.dtype)


def _peer(xn, wq, keys, u_tab, v_tab):
    bsz, s, d = xn.shape
    t = bsz * s
    xt = xn.reshape(t, d)
    q = (xt @ wq).reshape(t, PEER_HEADS, 2, PEER_HALF)
    sc = jnp.einsum('thkd,hknd->thkn', q, keys).astype(jnp.float32)
    s1, i1 = lax.top_k(sc[:, :, 0], PEER_TOPK)
    s2, i2 = lax.top_k(sc[:, :, 1], PEER_TOPK)
    cand = (s1[..., :, None] + s2[..., None, :]).reshape(t, PEER_HEADS, PEER_TOPK * PEER_TOPK)
    top_s, ci = lax.top_k(cand, PEER_TOPK)
    ia, ib = ci // PEER_TOPK, ci % PEER_TOPK
    experts = (jnp.take_along_axis(i1, ia, axis=-1) * PEER_NKEYS
               + jnp.take_along_axis(i2, ib, axis=-1))
    gates = jax.nn.softmax(top_s, axis=-1).astype(xn.dtype)
    nb = t // PEER_BLOCK

    def block(args):
        xb, eb, gb = args
        ub = u_tab[eb]
        act = _gelu(jnp.einsum('td,thkd->thk', xb, ub)) * gb
        vb = v_tab[eb]
        return jnp.einsum('thk,thkd->td', act, vb)

    y = lax.map(block, (xt.reshape(nb, PEER_BLOCK, d),
                        experts.reshape(nb, PEER_BLOCK, PEER_HEADS, PEER_TOPK),
                        gates.reshape(nb, PEER_BLOCK, PEER_HEADS, PEER_TOPK)))
    return y.reshape(bsz, s, d)


def setup_inputs(seed: int = 0) -> dict:
    key = jax.random.key(seed)
    ks = jax.random.split(key, 32)
    n = jax.random.normal
    L, D = DEPTH, D_MODEL
    G, P, C = N_SSM_GROUPS, SSM_STATE, SSM_GROUP
    a_im = jnp.broadcast_to(jnp.pi * jnp.arange(P, dtype=jnp.float32), (L, G, P))
    return {
        "x": n(ks[0], (BATCH, SEQ, D), jnp.float32),
        "p": n(ks[1], (DEPTH, BATCH, SEQ, PLE_DIM), jnp.float32),
        "ln_mix_g": 1.0 + 0.02 * n(ks[2], (L, D), jnp.float32),
        "w_in": n(ks[3], (L, D, D_IN), jnp.float32) * D ** -0.5,
        "s5_a_re": -0.5 + 0.01 * n(ks[4], (L, G, P), jnp.float32),
        "s5_a_im": a_im + 0.01 * n(ks[5], (L, G, P), jnp.float32),
        "s5_log_dt": jax.random.uniform(ks[6], (L, G), jnp.float32, math.log(1e-3), math.log(1e-1)),
        "s5_b_re": n(ks[7], (L, G, P, C), jnp.float32) * (2 * C) ** -0.5,
        "s5_b_im": n(ks[8], (L, G, P, C), jnp.float32) * (2 * C) ** -0.5,
        "s5_c_re": n(ks[9], (L, G, C, P), jnp.float32) * (2 * P) ** -0.5,
        "s5_c_im": n(ks[10], (L, G, C, P), jnp.float32) * (2 * P) ** -0.5,
        "s5_d": n(ks[11], (L, D_SSM), jnp.float32),
        "glu_w": n(ks[12], (L, D_SSM, D_SSM), jnp.float32) * D_SSM ** -0.5,
        "glu_b": 0.02 * n(ks[13], (L, D_SSM), jnp.float32),
        "sgu_ln_g": 1.0 + 0.02 * n(ks[14], (L, D_SGU), jnp.float32),
        "sgu_ln_b": 0.02 * n(ks[15], (L, D_SGU), jnp.float32),
        "sgu_ws": n(ks[16], (L, N_SGU_HEADS, SGU_CHUNK, SGU_CHUNK), jnp.float32) * SGU_CHUNK ** -0.5,
        "sgu_b": 1.0 + 0.02 * n(ks[17], (L, N_SGU_HEADS, SGU_CHUNK), jnp.float32),
        "out_norm_ssm": 1.0 + 0.02 * n(ks[18], (L, D_SSM), jnp.float32),
        "out_norm_sgu": 1.0 + 0.02 * n(ks[19], (L, D_SGU), jnp.float32),
        "w_out": n(ks[20], (L, D_MIX, D), jnp.float32) * D_MIX ** -0.5,
        "ln_ffn_g": 1.0 + 0.02 * n(ks[21], (L, D), jnp.float32),
        "peer_wq": n(ks[22], (L, D, PEER_HEADS * PEER_QDIM), jnp.float32) * D ** -0.5,
        "peer_keys": n(ks[23], (L, PEER_HEADS, 2, PEER_NKEYS, PEER_HALF), jnp.float32) * PEER_HALF ** -0.5,
        "peer_u": n(ks[24], (L, PEER_NEXPERTS, D), jnp.float32) * D ** -0.5,
        "peer_v": n(ks[25], (L, PEER_NEXPERTS, D), jnp.float32) * PEER_HEADS ** -0.5,
        "ple_norm_g": 1.0 + 0.02 * n(ks[26], (L, D), jnp.float32),
        "ple_w_gate": n(ks[27], (L, D, D), jnp.float32) * D ** -0.5,
        "ple_w_proj": n(ks[28], (L, PLE_DIM, D), jnp.float32) * PLE_DIM ** -0.5,
        "final_g": 1.0 + 0.02 * n(ks[29], (D,), jnp.float32),
    }


def reference(x, p, ln_mix_g, w_in, s5_a_re, s5_a_im, s5_log_dt, s5_b_re, s5_b_im,
              s5_c_re, s5_c_im, s5_d, glu_w, glu_b, sgu_ln_g, sgu_ln_b, sgu_ws, sgu_b,
              out_norm_ssm, out_norm_sgu, w_out, ln_ffn_g, peer_wq, peer_keys, peer_u,
              peer_v, ple_norm_g, ple_w_gate, ple_w_proj, final_g):
    h = x
    for i in range(DEPTH):
        xn = _rmsnorm(h, ln_mix_g[i])
        z = xn @ w_in[i]
        xs = z[..., :D_SSM]
        u = z[..., D_SSM:D_SSM + D_SGU]
        v = z[..., D_SSM + D_SGU:]
        ys = _s5(xs, s5_a_re[i], s5_a_im[i], s5_log_dt[i], s5_b_re[i], s5_b_im[i],
                 s5_c_re[i], s5_c_im[i], s5_d[i])
        ys = _gelu(ys)
        ys = ys * jax.nn.sigmoid(ys @ glu_w[i] + glu_b[i])
        yg = _sgu(u, v, sgu_ln_g[i], sgu_ln_b[i], sgu_ws[i], sgu_b[i])
        mix = jnp.concatenate([_rmsnorm(ys, out_norm_ssm[i]),
                               _rmsnorm(yg, out_norm_sgu[i])], axis=-1)
        h = h + mix @ w_out[i]
        hn = _rmsnorm(h, ln_ffn_g[i])
        h = h + _peer(hn, peer_wq[i], peer_keys[i], peer_u[i], peer_v[i])
        gate = jax.nn.sigmoid(_rmsnorm(h, ple_norm_g[i]) @ ple_w_gate[i])
        h = h + gate * (p[i] @ ple_w_proj[i])
    return _rmsnorm(h, final_g)
```

```cpp
#include <hip/hip_runtime.h>
#include <hip/hip_cooperative_groups.h>
#include <cstdio>
#include <cstdint>
namespace cg = cooperative_groups;

#ifndef PIPE_LEVEL
#define PIPE_LEVEL 3
#endif

#define LAS __attribute__((address_space(3)))
typedef unsigned short bf16_t;
typedef short bf16x8 __attribute__((ext_vector_type(8)));
typedef float f32x4 __attribute__((ext_vector_type(4)));
typedef unsigned u32x4 __attribute__((ext_vector_type(4)));
typedef unsigned u32x2 __attribute__((ext_vector_type(2)));

constexpr int T_TOK = 16 * 2048, SEQ = 2048, D = 1024, DIN = 1536;
constexpr int NG = 32;
constexpr int TILE = 128, NTILES = T_TOK / TILE, TPS = SEQ / TILE;
constexpr float EPS = 1e-6f;
constexpr int NTHREADS = 512;

constexpr size_t WS_WIN = 0;
constexpr size_t WS_WGLU = WS_WIN + (size_t)1536 * 1024 * 2;
constexpr size_t WS_WOUT = WS_WGLU + (size_t)512 * 512 * 2;
constexpr size_t WS_WQ = WS_WOUT + (size_t)1024 * 1024 * 2;
constexpr size_t WS_KEYS = WS_WQ + (size_t)2048 * 1024 * 2;
constexpr size_t WS_WGATE = WS_KEYS + (size_t)16 * 128 * 128 * 2;
constexpr size_t WS_WPROJ = WS_WGATE + (size_t)1024 * 1024 * 2;
constexpr size_t WS_WSM = WS_WPROJ + (size_t)1024 * 256 * 2;
constexpr size_t WS_TT = WS_WSM + (size_t)4 * 128 * 128 * 2;
constexpr size_t WS_WST = WS_TT + (size_t)32 * 128 * 256 * 2;
constexpr size_t WS_PW = WS_WST + (size_t)32 * 128 * 128 * 2;
constexpr size_t WS_STILE = WS_PW + (size_t)32 * 17 * 128 * 4;
constexpr size_t WS_UTAB = WS_STILE + (size_t)256 * 32 * 128 * 4;
constexpr size_t WS_VTAB = WS_UTAB + (size_t)16384 * 1024 * 2;
constexpr size_t WS_MIXA = WS_VTAB + (size_t)16384 * 1024 * 2;
constexpr size_t WS_HB = WS_MIXA + (size_t)T_TOK * 1024 * 2;
constexpr size_t WS_ARENA = WS_HB + (size_t)T_TOK * 1024 * 2;
constexpr size_t AR_XS = 0;
constexpr size_t AR_HLOC = 131072;
constexpr size_t AR_UG = 393216;
constexpr size_t AR_Q = 0;
constexpr size_t AR_PP = 0;
constexpr size_t AR_GV = 524288;
constexpr size_t AR_VNT = 655360;
constexpr size_t AR_HI = 786432;
constexpr size_t ARENA_BYTES = 917504;
constexpr size_t WS_END = WS_ARENA + (size_t)NTILES * ARENA_BYTES;

constexpr int LDS_MISC = 100352;
constexpr int LDS_BYTES = LDS_MISC + 4096;

struct Params {
    const float* in[30];
    float* out;
    unsigned char* ws;
};

__device__ __forceinline__ unsigned f2bf(float f) {
    unsigned u = __float_as_uint(f);
    return (u + 0x7fffu + ((u >> 16) & 1u)) >> 16;
}
__device__ __forceinline__ unsigned pk2(float lo, float hi) { return f2bf(lo) | (f2bf(hi) << 16); }
__device__ __forceinline__ float bflo(unsigned w) { return __uint_as_float(w << 16); }
__device__ __forceinline__ float bfhi(unsigned w) { return __uint_as_float(w & 0xffff0000u); }
__device__ __forceinline__ float bf2f(bf16_t b) { return __uint_as_float((unsigned)b << 16); }
__device__ __forceinline__ float wave_sum(float v) {
#pragma unroll
    for (int o = 1; o < 64; o <<= 1) v += __shfl_xor(v, o);
    return v;
}
__device__ __forceinline__ float gelu_f(float v) {
    const float av = fabsf(v);
    const float t = __builtin_amdgcn_rcpf(av * 0.2316418882f + 1.0f);
    float q = t * 0.5307027145f + (-0.7265760135f);
    q = q * t + 0.7107068705f; q = q * t + (-0.142248368f); q = q * t + 0.127414796f; q = q * t;
    const float e = __builtin_amdgcn_exp2f(v * v * (-0.72134752044f));
    const float m = v * (q * e);
    return v < 0.f ? m : v - m;
}
__device__ __forceinline__ float sigmoid_f(float x) {
    return __builtin_amdgcn_rcpf(1.0f + __builtin_amdgcn_exp2f(x * (-1.44269504089f)));
}
#define LDS_WAIT() asm volatile("s_waitcnt lgkmcnt(0)" ::: "memory")

template <int BN, bool TR, class Epi>
__device__ __forceinline__ void gemm_tile(const bf16_t* __restrict__ A, int lda, const bf16_t* __restrict__ Bt, int ldb, int K,
                                          LAS unsigned char* lds, const Epi& epi) {
    constexpr int NT = BN / 64;
    constexpr int BCH = BN / 64;
    constexpr int A_BYTES = 128 * 128;
    constexpr int B_BYTES = BN * 128;
    constexpr int B_OFF = 2 * A_BYTES;
    int tid = threadIdx.x;
    asm volatile("" : "+v"(tid));
    const int lane = tid & 63, wave = tid >> 6, wm = wave >> 2, wn = wave & 3;
    const int lrow = tid >> 3, lch = tid & 7;
    const int st_off = lrow * 128 + ((lch ^ ((lrow >> 1) & 7)) << 4);
    f32x4 acc[4][NT];
#pragma unroll
    for (int i = 0; i < 4; ++i)
#pragma unroll
        for (int j = 0; j < NT; ++j) acc[i][j] = (f32x4){0.f, 0.f, 0.f, 0.f};
    const bf16_t* ap = A + (size_t)lrow * lda + lch * 8;
    const bf16_t* bp = Bt + (size_t)lrow * ldb + lch * 8;
    u32x4 ra[2], rb[BCH];
#pragma unroll
    for (int i = 0; i < 2; ++i) ra[i] = *(const u32x4*)(ap + (size_t)(64 * i) * lda);
#pragma unroll
    for (int i = 0; i < BCH; ++i) rb[i] = *(const u32x4*)(bp + (size_t)(64 * i) * ldb);
#pragma unroll
    for (int i = 0; i < 2; ++i) *(LAS u32x4*)(lds + st_off + i * 64 * 128) = ra[i];
#pragma unroll
    for (int i = 0; i < BCH; ++i) *(LAS u32x4*)(lds + B_OFF + st_off + i * 64 * 128) = rb[i];
    __syncthreads();
    const int KT = K / 64;
    const int fr = lane & 15, fq = lane >> 4;
    const int fsw = (lane >> 1) & 7;
    for (int kt = 0; kt < KT; ++kt) {
        const int cur = kt & 1;
        if (kt + 1 < KT) {
            const int k0 = (kt + 1) * 64;
#pragma unroll
            for (int i = 0; i < 2; ++i) ra[i] = *(const u32x4*)(ap + (size_t)(64 * i) * lda + k0);
#pragma unroll
            for (int i = 0; i < BCH; ++i) rb[i] = *(const u32x4*)(bp + (size_t)(64 * i) * ldb + k0);
        }
        LAS unsigned char* la = lds + cur * A_BYTES + (wm * 64 + fr) * 128;
        LAS unsigned char* lb = lds + B_OFF + cur * B_BYTES + (wn * (BN / 4) + fr) * 128;
#pragma unroll
        for (int kk = 0; kk < 2; ++kk) {
            const int choff = ((kk * 4 + fq) ^ fsw) << 4;
            bf16x8 af[4], bfr[NT];
#pragma unroll
            for (int i = 0; i < 4; ++i) af[i] = *(LAS bf16x8*)(la + i * 16 * 128 + choff);
#pragma unroll
            for (int j = 0; j < NT; ++j) bfr[j] = *(LAS bf16x8*)(lb + j * 16 * 128 + choff);
#pragma unroll
            for (int i = 0; i < 4; ++i)
#pragma unroll
                for (int j = 0; j < NT; ++j) {
                    if (TR) acc[i][j] = __builtin_amdgcn_mfma_f32_16x16x32_bf16(bfr[j], af[i], acc[i][j], 0, 0, 0);
                    else    acc[i][j] = __builtin_amdgcn_mfma_f32_16x16x32_bf16(af[i], bfr[j], acc[i][j], 0, 0, 0);
                }
        }
        if (kt + 1 < KT) {
            const int nxt = cur ^ 1;
#pragma unroll
            for (int i = 0; i < 2; ++i) *(LAS u32x4*)(lds + nxt * A_BYTES + st_off + i * 64 * 128) = ra[i];
#pragma unroll
            for (int i = 0; i < BCH; ++i) *(LAS u32x4*)(lds + B_OFF + nxt * B_BYTES + st_off + i * 64 * 128) = rb[i];
        }
        __syncthreads();
    }
#pragma unroll
    for (int i = 0; i < 4; ++i)
#pragma unroll
        for (int j = 0; j < NT; ++j) {
            if (TR) epi(wm * 64 + i * 16 + fr, wn * (BN / 4) + j * 16 + 4 * fq, acc[i][j]);
            else    epi(wm * 64 + i * 16 + 4 * fq, wn * (BN / 4) + j * 16 + fr, acc[i][j]);
        }
}

__device__ __forceinline__ void transpose_item(const float* __restrict__ W, int K, int N, bf16_t* __restrict__ WT,
                                               const float* __restrict__ g1, const float* __restrict__ g2, int split,
                                               LAS float* scr, int item, int lane) {
    const int nblk = N / 32, kb = item / nblk, nb = item % nblk, k0 = 64 * kb, n0 = 32 * nb;
#pragma unroll 8
    for (int i = 0; i < 32; ++i) {
        const int kk = 2 * i + (lane >> 5), k = k0 + kk;
        float w = W[(size_t)k * N + n0 + (lane & 31)];
        if (g1) w *= (k < split) ? g1[k] : g2[k - split];
        scr[kk * 33 + (lane & 31)] = w;
    }
    LDS_WAIT();
    const int c = lane & 7;
#pragma unroll
    for (int j = 0; j < 4; ++j) {
        const int n = (lane >> 3) + 8 * j;
        const LAS float* s = scr + (8 * c) * 33 + n;
        u32x4 o;
        o.x = pk2(s[0 * 33], s[1 * 33]); o.y = pk2(s[2 * 33], s[3 * 33]);
        o.z = pk2(s[4 * 33], s[5 * 33]); o.w = pk2(s[6 * 33], s[7 * 33]);
        *(u32x4*)(WT + (size_t)(n0 + n) * K + k0 + 8 * c) = o;
    }
    LDS_WAIT();
}

__device__ __forceinline__ void s5_tables(const Params& p, LAS unsigned char* lds, int g) {
    const int tid = threadIdx.x;
    LAS float* apr = (LAS float*)lds;
    LAS float* api = apr + 9 * 64;
    LAS float* bbr = api + 9 * 64;
    LAS float* bbi = bbr + 1024;
    LAS float* ccr = bbi + 1024;
    LAS float* cci = ccr + 1024;
    LAS float* kk = cci + 1024;
    const float* a_re = p.in[4]; const float* a_im = p.in[5]; const float* log_dt = p.in[6];
    const float* b_re = p.in[7]; const float* b_im = p.in[8]; const float* c_re = p.in[9]; const float* c_im = p.in[10];
    const float* dsk = p.in[11];
    float* PW = (float*)(p.ws + WS_PW) + (size_t)g * 17 * 128;
    bf16_t* TT = (bf16_t*)(p.ws + WS_TT) + (size_t)g * 128 * 256;
    bf16_t* WST = (bf16_t*)(p.ws + WS_WST) + (size_t)g * 128 * 128;
    if (tid < 64) {
        const int n = tid;
        const float lr = a_re[g * 64 + n], li = a_im[g * 64 + n], dt = expf(log_dt[g]);
        const float mag = expf(lr * dt), ang = li * dt;
        float rev = ang * 0.15915494309189535f;
        rev = rev - floorf(rev);
        const float ar = mag * __builtin_amdgcn_cosf(rev), ai = mag * __builtin_amdgcn_sinf(rev);
        float pr = 1.f, pi = 0.f;
        apr[n] = pr; api[n] = pi;
        for (int k = 1; k <= 8; ++k) {
            const float nr = pr * ar - pi * ai, ni = pr * ai + pi * ar;
            pr = nr; pi = ni; apr[k * 64 + n] = pr; api[k * 64 + n] = pi;
        }
        const float a8r = pr, a8i = pi;
        float qr = 1.f, qi = 0.f;
        for (int c = 0; c <= 16; ++c) {
            PW[c * 128 + n] = qr; PW[c * 128 + 64 + n] = qi;
            const float nr = qr * a8r - qi * a8i, ni = qr * a8i + qi * a8r;
            qr = nr; qi = ni;
        }
        const float nr = ar - 1.0f, ni = ai, den = lr * lr + li * li;
        const float cr = (nr * lr + ni * li) / den, ci = (ni * lr - nr * li) / den;
        for (int c2 = 0; c2 < 16; ++c2) {
            const float br = b_re[(size_t)(g * 64 + n) * 16 + c2], bi = b_im[(size_t)(g * 64 + n) * 16 + c2];
            bbr[n * 16 + c2] = cr * br - ci * bi;
            bbi[n * 16 + c2] = cr * bi + ci * br;
        }
    }
    for (int i = tid; i < 1024; i += NTHREADS) { ccr[i] = c_re[(size_t)g * 1024 + i]; cci[i] = c_im[(size_t)g * 1024 + i]; }
    __syncthreads();
    for (int e = tid; e < 2048; e += NTHREADS) {
        const int k = e >> 8, c = (e >> 4) & 15, c2 = e & 15;
        float s = 0.f;
        for (int n = 0; n < 64; ++n) {
            const float pr = apr[k * 64 + n], pi = api[k * 64 + n], br = bbr[n * 16 + c2], bi = bbi[n * 16 + c2];
            const float tr = pr * br - pi * bi, ti = pr * bi + pi * br;
            s += ccr[c * 64 + n] * tr - cci[c * 64 + n] * ti;
        }
        if (k == 0 && c == c2) s += dsk[g * 16 + c];
        kk[e] = s;
    }
    __syncthreads();
    for (int e = tid; e < 128 * 256; e += NTHREADS) {
        const int row = e >> 8, col = e & 255, tau = row >> 4, c = row & 15;
        float v;
        if (col < 128) {
            const int sg = col >> 4, c2 = col & 15;
            v = (tau >= sg) ? kk[((tau - sg) << 8) + (c << 4) + c2] : 0.f;
        } else {
            const int n = col & 63;
            const float pr = apr[(tau + 1) * 64 + n], pi = api[(tau + 1) * 64 + n];
            const float cr = ccr[c * 64 + n], ci = cci[c * 64 + n];
            v = (col < 192) ? (cr * pr - ci * pi) : -(cr * pi + ci * pr);
        }
        TT[e] = (bf16_t)f2bf(v);
    }
    for (int e = tid; e < 128 * 128; e += NTHREADS) {
        const int row = e >> 7, col = e & 127, part = row >> 6, n = row & 63, sg = col >> 4, c2 = col & 15;
        const float pr = apr[(7 - sg) * 64 + n], pi = api[(7 - sg) * 64 + n], br = bbr[n * 16 + c2], bi = bbi[n * 16 + c2];
        const float v = part ? (pr * bi + pi * br) : (pr * br - pi * bi);
        WST[e] = (bf16_t)f2bf(v);
    }
    __syncthreads();
}

__device__ __forceinline__ void phase0(const Params& p, LAS unsigned char* lds) {
    const int tid = threadIdx.x, lane = tid & 63, wave = tid >> 6;
    unsigned char* ws = p.ws;
    for (int g = blockIdx.x; g < NG; g += gridDim.x) s5_tables(p, lds, g);
    {
        LAS float* scr = (LAS float*)(lds + wave * 8448);
        const int gw = blockIdx.x * 8 + wave, ngw = gridDim.x * 8;
        constexpr int I0 = 16 * 48, I1 = 8 * 16, I2 = 16 * 32, I3 = 16 * 64, I4 = 16 * 32, I5 = 4 * 32;
        for (int it = gw; it < I0 + I1 + I2 + I3 + I4 + I5; it += ngw) {
            int r = it;
            if (r < I0) { transpose_item(p.in[3], 1024, 1536, (bf16_t*)(ws + WS_WIN), p.in[2], p.in[2], 1024, scr, r, lane); continue; } r -= I0;
            if (r < I1) { transpose_item(p.in[12], 512, 512, (bf16_t*)(ws + WS_WGLU), nullptr, nullptr, 0, scr, r, lane); continue; } r -= I1;
            if (r < I2) { transpose_item(p.in[20], 1024, 1024, (bf16_t*)(ws + WS_WOUT), p.in[18], p.in[19], 512, scr, r, lane); continue; } r -= I2;
            if (r < I3) { transpose_item(p.in[22], 1024, 2048, (bf16_t*)(ws + WS_WQ), p.in[21], p.in[21], 1024, scr, r, lane); continue; } r -= I3;
            if (r < I4) { transpose_item(p.in[27], 1024, 1024, (bf16_t*)(ws + WS_WGATE), p.in[26], p.in[26], 1024, scr, r, lane); continue; } r -= I4;
            transpose_item(p.in[28], 256, 1024, (bf16_t*)(ws + WS_WPROJ), nullptr, nullptr, 0, scr, r, lane);
        }
    }
    const size_t gt = (size_t)blockIdx.x * NTHREADS + tid, ngt = (size_t)gridDim.x * NTHREADS;
    {
        const float4* src = (const float4*)p.in[23]; u32x2* dst = (u32x2*)(ws + WS_KEYS);
        for (size_t i = gt; i < 65536; i += ngt) { const float4 v = src[i]; dst[i] = (u32x2){pk2(v.x, v.y), pk2(v.z, v.w)}; }
    }
    {
        const float4* src = (const float4*)p.in[16]; u32x2* dst = (u32x2*)(ws + WS_WSM);
        for (size_t i = gt; i < 16384; i += ngt) {
            float4 v = src[i];
            const int t = (int)((i >> 5) & 127), s0 = (int)(i & 31) * 4;
            if (s0 + 0 > t) v.x = 0.f; if (s0 + 1 > t) v.y = 0.f; if (s0 + 2 > t) v.z = 0.f; if (s0 + 3 > t) v.w = 0.f;
            dst[i] = (u32x2){pk2(v.x, v.y), pk2(v.z, v.w)};
        }
    }
    {
        const float4* su = (const float4*)p.in[24]; const float4* sv = (const float4*)p.in[25];
        const float4* g4 = (const float4*)p.in[21];
        u32x2* du = (u32x2*)(ws + WS_UTAB); u32x2* dv = (u32x2*)(ws + WS_VTAB);
        for (size_t i = gt; i < (size_t)16384 * 256; i += ngt) {
            float4 v = su[i]; const float4 g = g4[i & 255];
            du[i] = (u32x2){pk2(v.x * g.x, v.y * g.y), pk2(v.z * g.z, v.w * g.w)};
            v = sv[i];
            dv[i] = (u32x2){pk2(v.x, v.y), pk2(v.z, v.w)};
        }
    }
}

__device__ __forceinline__ void phase1(const Params& p, LAS unsigned char* lds, int tile) {
    int tid = threadIdx.x;
    asm volatile("" : "+v"(tid));
    const int lane = tid & 63, wave = tid >> 6;
    unsigned char* ws = p.ws;
    const size_t tok0 = (size_t)tile * TILE;
    unsigned char* arena = ws + WS_ARENA + (size_t)tile * ARENA_BYTES;
    bf16_t* XB = (bf16_t*)(ws + WS_HB) + tok0 * 1024;
    bf16_t* XS = (bf16_t*)(arena + AR_XS);
    bf16_t* UG = (bf16_t*)(arena + AR_UG);
    bf16_t* GVT = (bf16_t*)(arena + AR_GV);
    float* HLOC = (float*)(arena + AR_HLOC);
    bf16_t* MIXA = (bf16_t*)(ws + WS_MIXA) + tok0 * 1024;
    LAS float* rs = (LAS float*)(lds + LDS_MISC);
    const float* x = p.in[0];

    for (int r = wave; r < TILE; r += 8) {
        const float4* xr = (const float4*)(x + (tok0 + r) * 1024);
        float ss = 0.f;
#pragma unroll
        for (int j = 0; j < 2; ++j) {
            const float4 a = xr[lane * 2 + 128 * j], b = xr[lane * 2 + 1 + 128 * j];
            ss += a.x * a.x + a.y * a.y + a.z * a.z + a.w * a.w + b.x * b.x + b.y * b.y + b.z * b.z + b.w * b.w;
            *(u32x4*)(XB + (size_t)r * 1024 + lane * 8 + 512 * j) = (u32x4){pk2(a.x, a.y), pk2(a.z, a.w), pk2(b.x, b.y), pk2(b.z, b.w)};
        }
        ss = wave_sum(ss);
        if (lane == 0) rs[r] = rsqrtf(ss * (1.0f / 1024.0f) + EPS);
    }
    __syncthreads();

    const bf16_t* WIN = (const bf16_t*)(ws + WS_WIN);
    for (int nc = 0; nc < 2; ++nc) {
        const int n0 = nc * 256;
        gemm_tile<256, true>(XB, 1024, WIN + (size_t)n0 * 1024, 1024, 1024, lds, [=](int row, int col, f32x4 v) {
            const float r = rs[row];
            const int gc = n0 + col, g = gc >> 4, c0 = gc & 15;
            *(u32x2*)(XS + ((size_t)g * 128 + row) * 16 + c0) = (u32x2){pk2(v[0] * r, v[1] * r), pk2(v[2] * r, v[3] * r)};
        });
    }
    for (int nc = 2; nc < 4; ++nc) {
        const int n0 = nc * 256;
        gemm_tile<256, true>(XB, 1024, WIN + (size_t)n0 * 1024, 1024, 1024, lds, [=](int row, int col, f32x4 v) {
            const float r = rs[row];
            const int gc = n0 + col - 512;
            *(u32x2*)(UG + (size_t)row * 512 + gc) = (u32x2){pk2(gelu_f(v[0] * r), gelu_f(v[1] * r)), pk2(gelu_f(v[2] * r), gelu_f(v[3] * r))};
        });
    }
    for (int nc = 4; nc < 6; ++nc) {
        const int n0 = nc * 256;
        gemm_tile<256, false>(XB, 1024, WIN + (size_t)n0 * 1024, 1024, 1024, lds, [=](int row, int col, f32x4 v) {
            const int gc = n0 + col - 1024;
            *(u32x2*)(GVT + (size_t)gc * 128 + row) = (u32x2){pk2(gelu_f(v[0] * rs[row]), gelu_f(v[1] * rs[row + 1])),
                                                              pk2(gelu_f(v[2] * rs[row + 2]), gelu_f(v[3] * rs[row + 3]))};
        });
    }
    __syncthreads();

    LAS float* stat = (LAS float*)lds;
    {
        const int s = tid & 127, head = tid >> 7;
        float sum = 0.f, sq = 0.f;
        for (int d = 0; d < 128; ++d) { const float v = bf2f(GVT[(size_t)(head * 128 + d) * 128 + s]); sum += v; sq += v * v; }
        const float mu = sum * (1.0f / 128.0f), var = sq * (1.0f / 128.0f) - mu * mu;
        stat[(head * 128 + s) * 2] = mu; stat[(head * 128 + s) * 2 + 1] = rsqrtf(fmaxf(var, 0.f) + EPS);
    }
    __syncthreads();
    {
        const float* lng = p.in[14]; const float* lnb = p.in[15];
        for (int c = tid; c < 8192; c += NTHREADS) {
            const int hd = c >> 4, s0 = (c & 15) * 8, head = hd >> 7;
            u32x4 w = *(u32x4*)(GVT + (size_t)hd * 128 + s0);
            const float g = lng[hd], b = lnb[hd];
            float o[8];
            const unsigned ww[4] = {w.x, w.y, w.z, w.w};
#pragma unroll
            for (int i = 0; i < 4; ++i) {
                const float mu0 = stat[(head * 128 + s0 + 2 * i) * 2], r0 = stat[(head * 128 + s0 + 2 * i) * 2 + 1];
                const float mu1 = stat[(head * 128 + s0 + 2 * i + 1) * 2], r1 = stat[(head * 128 + s0 + 2 * i + 1) * 2 + 1];
                o[2 * i] = (bflo(ww[i]) - mu0) * r0 * g + b;
                o[2 * i + 1] = (bfhi(ww[i]) - mu1) * r1 * g + b;
            }
            *(u32x4*)(GVT + (size_t)hd * 128 + s0) = (u32x4){pk2(o[0], o[1]), pk2(o[2], o[3]), pk2(o[4], o[5]), pk2(o[6], o[7])};
        }
    }
    __syncthreads();

    {
        const bf16_t* WSM = (const bf16_t*)(ws + WS_WSM);
        const float* bs = p.in[17];
        for (int head = 0; head < 4; ++head) {
            gemm_tile<128, true>(WSM + (size_t)head * 16384, 128, GVT + (size_t)head * 16384, 128, 128, lds, [=](int row, int col, f32x4 v) {
                const float b = bs[head * 128 + row];
                const u32x2 uu = *(const u32x2*)(UG + (size_t)row * 512 + head * 128 + col);
                const float y0 = bflo(uu.x) * (v[0] + b), y1 = bfhi(uu.x) * (v[1] + b), y2 = bflo(uu.y) * (v[2] + b), y3 = bfhi(uu.y) * (v[3] + b);
                *(u32x2*)(MIXA + (size_t)row * 1024 + 512 + head * 128 + col) = (u32x2){pk2(y0, y1), pk2(y2, y3)};
            });
        }
    }
    __syncthreads();
    for (int r = wave; r < TILE; r += 8) {
        bf16_t* yr = MIXA + (size_t)r * 1024 + 512 + lane * 8;
        const u32x4 w = *(u32x4*)yr;
        float f[8] = {bflo(w.x), bfhi(w.x), bflo(w.y), bfhi(w.y), bflo(w.z), bfhi(w.z), bflo(w.w), bfhi(w.w)};
        float ss = 0.f;
#pragma unroll
        for (int i = 0; i < 8; ++i) ss += f[i] * f[i];
        ss = wave_sum(ss);
        const float rr = rsqrtf(ss * (1.0f / 512.0f) + EPS);
        *(u32x4*)yr = (u32x4){pk2(f[0] * rr, f[1] * rr), pk2(f[2] * rr, f[3] * rr), pk2(f[4] * rr, f[5] * rr), pk2(f[6] * rr, f[7] * rr)};
    }
    {
        const bf16_t* WSTb = (const bf16_t*)(ws + WS_WST);
        const float* PW = (const float*)(ws + WS_PW);
        float* STILE = (float*)(ws + WS_STILE) + (size_t)tile * NG * 128;
        LAS float* sl = (LAS float*)(lds + wave * 8192);
        const int fr = lane & 15, fq = lane >> 4;
        for (int g = wave; g < NG; g += 8) {
            f32x4 acc[8];
#pragma unroll
            for (int j = 0; j < 8; ++j) acc[j] = (f32x4){0.f, 0.f, 0.f, 0.f};
            const bf16_t* abase = XS + (size_t)g * 2048 + fr * 128 + fq * 8;
            const bf16_t* bbase = WSTb + (size_t)g * 16384 + (size_t)fr * 128 + fq * 8;
#pragma unroll
            for (int ks = 0; ks < 4; ++ks) {
                const bf16x8 af = *(const bf16x8*)(abase + ks * 32);
#pragma unroll
                for (int j = 0; j < 8; ++j) {
                    const bf16x8 bfr = *(const bf16x8*)(bbase + (size_t)j * 16 * 128 + ks * 32);
                    acc[j] = __builtin_amdgcn_mfma_f32_16x16x32_bf16(bfr, af, acc[j], 0, 0, 0);
                }
            }
#pragma unroll
            for (int j = 0; j < 8; ++j) *(LAS f32x4*)(sl + fr * 128 + 16 * j + 4 * fq) = acc[j];
            LDS_WAIT();
            const float a8r = PW[(size_t)g * 17 * 128 + 128 + lane], a8i = PW[(size_t)g * 17 * 128 + 128 + 64 + lane];
            float hr = 0.f, hi = 0.f;
            for (int c = 0; c < 16; ++c) {
                HLOC[((size_t)g * 16 + c) * 128 + lane] = hr; HLOC[((size_t)g * 16 + c) * 128 + 64 + lane] = hi;
                const float sr = sl[c * 128 + lane], si = sl[c * 128 + 64 + lane];
                const float nr = a8r * hr - a8i * hi + sr, ni = a8r * hi + a8i * hr + si;
                hr = nr; hi = ni;
            }
            STILE[(size_t)g * 128 + lane] = hr; STILE[(size_t)g * 128 + 64 + lane] = hi;
            LDS_WAIT();
        }
    }
    __syncthreads();
}

__device__ __forceinline__ void final_rows(const Params& p, size_t tok0) {
    const int lane = threadIdx.x & 63, wave = threadIdx.x >> 6;
    const float4* g4 = (const float4*)p.in[29];
    for (int r = wave; r < TILE; r += 8) {
        float4* hr = (float4*)(p.out + (tok0 + r) * 1024);
        float4 v[4]; float ss = 0.f;
#pragma unroll
        for (int j = 0; j < 4; ++j) { v[j] = hr[lane + 64 * j]; ss += v[j].x * v[j].x + v[j].y * v[j].y + v[j].z * v[j].z + v[j].w * v[j].w; }
        ss = wave_sum(ss);
        const float rr = rsqrtf(ss * (1.0f / 1024.0f) + EPS);
#pragma unroll
        for (int j = 0; j < 4; ++j) {
            const float4 g = g4[lane + 64 * j];
            v[j].x *= rr * g.x; v[j].y *= rr * g.y; v[j].z *= rr * g.z; v[j].w *= rr * g.w;
            hr[lane + 64 * j] = v[j];
        }
    }
}

__device__ __forceinline__ unsigned ord_key(float f) { const unsigned u = __float_as_uint(f); return (u & 0x80000000u) ? ~u : (u | 0x80000000u); }
__device__ __forceinline__ float ord_val(unsigned k) { return (k & 0x80000000u) ? __uint_as_float(k & 0x7fffffffu) : __uint_as_float(~k); }

__device__ __forceinline__ void phase2(const Params& p, LAS unsigned char* lds, int tile) {
    int tid = threadIdx.x;
    asm volatile("" : "+v"(tid));
    const int lane = tid & 63, wave = tid >> 6;
    unsigned char* ws = p.ws;
    const size_t tok0 = (size_t)tile * TILE;
    unsigned char* arena = ws + WS_ARENA + (size_t)tile * ARENA_BYTES;
    bf16_t* HB = (bf16_t*)(ws + WS_HB) + tok0 * 1024;
    bf16_t* XS = (bf16_t*)(arena + AR_XS);
    float* HLOC = (float*)(arena + AR_HLOC);
    bf16_t* HI = (bf16_t*)(arena + AR_HI);
    bf16_t* YS = (bf16_t*)(arena + AR_GV);
    bf16_t* MIXA = (bf16_t*)(ws + WS_MIXA) + tok0 * 1024;
    float* OUT = p.out + tok0 * 1024;
    const float* x = p.in[0] + tok0 * 1024;
    LAS float* rs = (LAS float*)(lds + LDS_MISC);
    LAS float* rs2 = (LAS float*)(lds + LDS_MISC + 512);
    const float* PW = (const float*)(ws + WS_PW);

    {
        const int ti = tile & (TPS - 1);
        const float* STILE = (const float*)(ws + WS_STILE) + (size_t)(tile - ti) * NG * 128;
        for (int idx = tid; idx < NG * 64; idx += NTHREADS) {
            const int g = idx >> 6, n = idx & 63;
            const float* pw = PW + (size_t)g * 17 * 128;
            const float ar = pw[16 * 128 + n], ai = pw[16 * 128 + 64 + n];
            float hr = 0.f, hi = 0.f;
            for (int j = 0; j < ti; ++j) {
                const float sr = STILE[((size_t)j * NG + g) * 128 + n], si = STILE[((size_t)j * NG + g) * 128 + 64 + n];
                const float nr = ar * hr - ai * hi + sr, ni = ar * hi + ai * hr + si;
                hr = nr; hi = ni;
            }
            for (int c = 0; c < 16; ++c) {
                const float qr = pw[c * 128 + n], qi = pw[c * 128 + 64 + n];
                const float vr = qr * hr - qi * hi + HLOC[((size_t)g * 16 + c) * 128 + n];
                const float vi = qr * hi + qi * hr + HLOC[((size_t)g * 16 + c) * 128 + 64 + n];
                HI[((size_t)g * 16 + c) * 128 + n] = (bf16_t)f2bf(vr);
                HI[((size_t)g * 16 + c) * 128 + 64 + n] = (bf16_t)f2bf(vi);
            }
        }
    }
    __syncthreads();
    {
        const bf16_t* TTb = (const bf16_t*)(ws + WS_TT);
        const int fr = lane & 15, fq = lane >> 4;
        for (int g = wave; g < NG; g += 8) {
            f32x4 acc[8];
#pragma unroll
            for (int j = 0; j < 8; ++j) acc[j] = (f32x4){0.f, 0.f, 0.f, 0.f};
            const bf16_t* a0 = XS + (size_t)g * 2048 + fr * 128 + fq * 8;
            const bf16_t* a1 = HI + (size_t)g * 2048 + fr * 128 + fq * 8;
            const bf16_t* bbase = TTb + (size_t)g * 32768 + (size_t)fr * 256 + fq * 8;
#pragma unroll
            for (int ks = 0; ks < 8; ++ks) {
                const bf16x8 af = (ks < 4) ? *(const bf16x8*)(a0 + ks * 32) : *(const bf16x8*)(a1 + (ks - 4) * 32);
#pragma unroll
                for (int j = 0; j < 8; ++j) {
                    const bf16x8 bfr = *(const bf16x8*)(bbase + (size_t)j * 16 * 256 + ks * 32);
                    acc[j] = __builtin_amdgcn_mfma_f32_16x16x32_bf16(bfr, af, acc[j], 0, 0, 0);
                }
            }
#pragma unroll
            for (int j = 0; j < 8; ++j) {
                const f32x4 v = acc[j];
                *(u32x2*)(YS + (size_t)(fr * 8 + j) * 512 + g * 16 + 4 * fq) = (u32x2){pk2(gelu_f(v[0]), gelu_f(v[1])), pk2(gelu_f(v[2]), gelu_f(v[3]))};
            }
        }
    }
    __syncthreads();
    {
        const bf16_t* WGLU = (const bf16_t*)(ws + WS_WGLU);
        const float* gb = p.in[13];
        for (int nc = 0; nc < 2; ++nc) {
            const int n0 = nc * 256;
            gemm_tile<256, true>(YS, 512, WGLU + (size_t)n0 * 512, 512, 512, lds, [=](int row, int col, f32x4 v) {
                const int gc = n0 + col;
                const u32x2 yy = *(const u32x2*)(YS + (size_t)row * 512 + gc);
                const float4 b = *(const float4*)(gb + gc);
                const float y0 = bflo(yy.x) * sigmoid_f(v[0] + b.x), y1 = bfhi(yy.x) * sigmoid_f(v[1] + b.y);
                const float y2 = bflo(yy.y) * sigmoid_f(v[2] + b.z), y3 = bfhi(yy.y) * sigmoid_f(v[3] + b.w);
                *(u32x2*)(MIXA + (size_t)row * 1024 + gc) = (u32x2){pk2(y0, y1), pk2(y2, y3)};
            });
        }
    }
    __syncthreads();
    for (int r = wave; r < TILE; r += 8) {
        bf16_t* yr = MIXA + (size_t)r * 1024 + lane * 8;
        const u32x4 w = *(u32x4*)yr;
        float f[8] = {bflo(w.x), bfhi(w.x), bflo(w.y), bfhi(w.y), bflo(w.z), bfhi(w.z), bflo(w.w), bfhi(w.w)};
        float ss = 0.f;
#pragma unroll
        for (int i = 0; i < 8; ++i) ss += f[i] * f[i];
        ss = wave_sum(ss);
        const float rr = rsqrtf(ss * (1.0f / 512.0f) + EPS);
        *(u32x4*)yr = (u32x4){pk2(f[0] * rr, f[1] * rr), pk2(f[2] * rr, f[3] * rr), pk2(f[4] * rr, f[5] * rr), pk2(f[6] * rr, f[7] * rr)};
    }
    __syncthreads();
    {
        const bf16_t* WOUT = (const bf16_t*)(ws + WS_WOUT);
        for (int nc = 0; nc < 4; ++nc) {
            const int n0 = nc * 256;
            gemm_tile<256, true>(MIXA, 1024, WOUT + (size_t)n0 * 1024, 1024, 1024, lds, [=](int row, int col, f32x4 v) {
                const float4 xx = *(const float4*)(x + (size_t)row * 1024 + n0 + col);
                *(float4*)(OUT + (size_t)row * 1024 + n0 + col) = make_float4(xx.x + v[0], xx.y + v[1], xx.z + v[2], xx.w + v[3]);
            });
        }
    }
    __syncthreads();
#if PIPE_LEVEL >= 2
    for (int r = wave; r < TILE; r += 8) {
        const float4* hr = (const float4*)(OUT + (size_t)r * 1024);
        float ss = 0.f;
#pragma unroll
        for (int j = 0; j < 2; ++j) {
            const float4 a = hr[lane * 2 + 128 * j], b = hr[lane * 2 + 1 + 128 * j];
            ss += a.x * a.x + a.y * a.y + a.z * a.z + a.w * a.w + b.x * b.x + b.y * b.y + b.z * b.z + b.w * b.w;
            *(u32x4*)(HB + (size_t)r * 1024 + lane * 8 + 512 * j) = (u32x4){pk2(a.x, a.y), pk2(a.z, a.w), pk2(b.x, b.y), pk2(b.z, b.w)};
        }
        ss = wave_sum(ss);
        if (lane == 0) rs[r] = rsqrtf(ss * (1.0f / 1024.0f) + EPS);
    }
    __syncthreads();
#endif
#if PIPE_LEVEL >= 3
    bf16_t* Q = (bf16_t*)(arena + AR_Q);
    {
        const bf16_t* WQ = (const bf16_t*)(ws + WS_WQ);
        for (int nc = 0; nc < 8; ++nc) {
            const int n0 = nc * 256;
            gemm_tile<256, true>(HB, 1024, WQ + (size_t)n0 * 1024, 1024, 1024, lds, [=](int row, int col, f32x4 v) {
                const float r = rs[row];
                *(u32x2*)(Q + (size_t)row * 2048 + n0 + col) = (u32x2){pk2(v[0] * r, v[1] * r), pk2(v[2] * r, v[3] * r)};
            });
        }
    }
    __syncthreads();
    unsigned* TOPK = (unsigned*)(arena + AR_GV);
    {
        const bf16_t* KEYS = (const bf16_t*)(ws + WS_KEYS);
        LAS float* sc = (LAS float*)lds;
        LAS unsigned* lst = (LAS unsigned*)(lds + 66048);
        for (int combo = 0; combo < 16; ++combo) {
            gemm_tile<128, true>(Q + combo * 128, 2048, KEYS + (size_t)combo * 16384, 128, 128, lds, [=](int row, int col, f32x4 v) {
                sc[row * 129 + col] = v[0]; sc[row * 129 + col + 1] = v[1]; sc[row * 129 + col + 2] = v[2]; sc[row * 129 + col + 3] = v[3];
            });
            __syncthreads();
            {
                const int row = tid >> 2, q4 = tid & 3;
                unsigned l[16];
#pragma unroll
                for (int j = 0; j < 16; ++j) l[j] = 0u;
                for (int i = 0; i < 32; ++i) {
                    const int n = q4 * 32 + i;
                    unsigned xk = (ord_key(sc[row * 129 + n]) & 0xFFFFFF80u) | (unsigned)(127 - n);
#pragma unroll
                    for (int j = 0; j < 16; ++j) { const unsigned hi = max(l[j], xk); xk = min(l[j], xk); l[j] = hi; }
                }
#pragma unroll
                for (int j = 0; j < 16; ++j) lst[(row * 4 + q4) * 16 + j] = l[j];
            }
            __syncthreads();
            if (tid < 128) {
                const int row = tid;
                int p0 = 0, p1 = 0, p2 = 0, p3 = 0;
                LAS unsigned* b = lst + row * 64;
                for (int j = 0; j < 16; ++j) {
                    const unsigned k0 = p0 < 16 ? b[p0] : 0u, k1 = p1 < 16 ? b[16 + p1] : 0u, k2 = p2 < 16 ? b[32 + p2] : 0u, k3 = p3 < 16 ? b[48 + p3] : 0u;
                    const unsigned m = max(max(k0, k1), max(k2, k3));
                    if (m == k0) ++p0; else if (m == k1) ++p1; else if (m == k2) ++p2; else ++p3;
                    TOPK[((size_t)row * 16 + combo) * 16 + j] = m;
                }
            }
            __syncthreads();
        }
    }
    int* EIDX = (int*)(arena + AR_VNT);
    float* EGATE = (float*)(arena + AR_VNT + 65536);
    for (int pr = tid; pr < 128 * 8; pr += NTHREADS) {
        const int row = pr >> 3, h = pr & 7;
        const unsigned* k1 = TOPK + ((size_t)row * 16 + h * 2) * 16;
        const unsigned* k2 = k1 + 16;
        float s1[16], s2[16];
#pragma unroll
        for (int j = 0; j < 16; ++j) { s1[j] = ord_val(k1[j] & 0xFFFFFF80u); s2[j] = ord_val(k2[j] & 0xFFFFFF80u); }
        unsigned l[16];
#pragma unroll
        for (int j = 0; j < 16; ++j) l[j] = 0u;
#pragma unroll
        for (int a = 0; a < 16; ++a)
#pragma unroll
            for (int b = 0; b < 16; ++b)
                if ((a + 1) * (b + 1) <= 16) {
                    unsigned xk = (ord_key(s1[a] + s2[b]) & 0xFFFFFF00u) | (unsigned)(255 - (a * 16 + b));
#pragma unroll
                    for (int j = 0; j < 16; ++j) { const unsigned hi = max(l[j], xk); xk = min(l[j], xk); l[j] = hi; }
                }
        float ev[16]; float mx = ord_val(l[0] & 0xFFFFFF00u), sum = 0.f;
#pragma unroll
        for (int j = 0; j < 16; ++j) { ev[j] = __expf(ord_val(l[j] & 0xFFFFFF00u) - mx); sum += ev[j]; }
        const float inv = 1.0f / sum;
#pragma unroll
        for (int j = 0; j < 16; ++j) {
            const int ab = 255 - (int)(l[j] & 255u), a = ab >> 4, b = ab & 15;
            const int i1 = 127 - (int)(k1[a] & 127u), i2 = 127 - (int)(k2[b] & 127u);
            EIDX[(size_t)row * 128 + h * 16 + j] = i1 * 128 + i2;
            EGATE[(size_t)row * 128 + h * 16 + j] = ev[j] * inv;
        }
    }
    __syncthreads();
    {
        const bf16_t* UT = (const bf16_t*)(ws + WS_UTAB);
        const bf16_t* VT = (const bf16_t*)(ws + WS_VTAB);
        for (int tt = 0; tt < 16; ++tt) {
            const int row = wave * 16 + tt;
            float* hrow = OUT + (size_t)row * 1024;
            float xr[16];
#pragma unroll
            for (int j = 0; j < 2; ++j) {
                const float4 a = *(const float4*)(hrow + lane * 8 + 512 * j), b = *(const float4*)(hrow + lane * 8 + 512 * j + 4);
                xr[8 * j + 0] = a.x; xr[8 * j + 1] = a.y; xr[8 * j + 2] = a.z; xr[8 * j + 3] = a.w;
                xr[8 * j + 4] = b.x; xr[8 * j + 5] = b.y; xr[8 * j + 6] = b.z; xr[8 * j + 7] = b.w;
            }
            const float rstd = rs[row];
            const int mi0 = EIDX[(size_t)row * 128 + lane], mi1 = EIDX[(size_t)row * 128 + 64 + lane];
            const float mg0 = EGATE[(size_t)row * 128 + lane], mg1 = EGATE[(size_t)row * 128 + 64 + lane];
            float act0 = 0.f, act1 = 0.f;
#pragma unroll
            for (int jj = 0; jj < 2; ++jj) {
                const int mi = jj ? mi1 : mi0; const float mg = jj ? mg1 : mg0;
#pragma unroll 4
                for (int e = 0; e < 64; ++e) {
                    const int idx = __builtin_amdgcn_readlane(mi, e);
                    const u32x4* ur = (const u32x4*)(UT + (size_t)idx * 1024 + lane * 8);
                    const u32x4 a = ur[0], b = ur[64];
                    float s = bflo(a.x) * xr[0] + bfhi(a.x) * xr[1] + bflo(a.y) * xr[2] + bfhi(a.y) * xr[3]
                            + bflo(a.z) * xr[4] + bfhi(a.z) * xr[5] + bflo(a.w) * xr[6] + bfhi(a.w) * xr[7]
                            + bflo(b.x) * xr[8] + bfhi(b.x) * xr[9] + bflo(b.y) * xr[10] + bfhi(b.y) * xr[11]
                            + bflo(b.z) * xr[12] + bfhi(b.z) * xr[13] + bflo(b.w) * xr[14] + bfhi(b.w) * xr[15];
                    s = wave_sum(s);
                    const float gate = __uint_as_float(__builtin_amdgcn_readlane(__float_as_uint(mg), e));
                    const float act = gelu_f(s * rstd) * gate;
                    if (lane == e) { if (jj) act1 = act; else act0 = act; }
                }
            }
            float y[16];
#pragma unroll
            for (int i = 0; i < 16; ++i) y[i] = 0.f;
#pragma unroll
            for (int jj = 0; jj < 2; ++jj) {
                const int mi = jj ? mi1 : mi0; const float ma = jj ? act1 : act0;
#pragma unroll 4
                for (int e = 0; e < 64; ++e) {
                    const int idx = __builtin_amdgcn_readlane(mi, e);
                    const float act = __uint_as_float(__builtin_amdgcn_readlane(__float_as_uint(ma), e));
                    const u32x4* vr = (const u32x4*)(VT + (size_t)idx * 1024 + lane * 8);
                    const u32x4 a = vr[0], b = vr[64];
                    y[0] += act * bflo(a.x); y[1] += act * bfhi(a.x); y[2] += act * bflo(a.y); y[3] += act * bfhi(a.y);
                    y[4] += act * bflo(a.z); y[5] += act * bfhi(a.z); y[6] += act * bflo(a.w); y[7] += act * bfhi(a.w);
                    y[8] += act * bflo(b.x); y[9] += act * bfhi(b.x); y[10] += act * bflo(b.y); y[11] += act * bfhi(b.y);
                    y[12] += act * bflo(b.z); y[13] += act * bfhi(b.z); y[14] += act * bflo(b.w); y[15] += act * bfhi(b.w);
                }
            }
            float ss = 0.f;
#pragma unroll
            for (int i = 0; i < 16; ++i) { y[i] += xr[i]; ss += y[i] * y[i]; }
            ss = wave_sum(ss);
#pragma unroll
            for (int j = 0; j < 2; ++j) {
                *(float4*)(hrow + lane * 8 + 512 * j) = make_float4(y[8 * j], y[8 * j + 1], y[8 * j + 2], y[8 * j + 3]);
                *(float4*)(hrow + lane * 8 + 512 * j + 4) = make_float4(y[8 * j + 4], y[8 * j + 5], y[8 * j + 6], y[8 * j + 7]);
                *(u32x4*)(HB + (size_t)row * 1024 + lane * 8 + 512 * j) =
                    (u32x4){pk2(y[8 * j], y[8 * j + 1]), pk2(y[8 * j + 2], y[8 * j + 3]), pk2(y[8 * j + 4], y[8 * j + 5]), pk2(y[8 * j + 6], y[8 * j + 7])};
            }
            if (lane == 0) rs2[row] = rsqrtf(ss * (1.0f / 1024.0f) + EPS);
        }
    }
    __syncthreads();
#elif PIPE_LEVEL == 2
    for (int r = tid; r < TILE; r += NTHREADS) rs2[r] = rs[r];
    __syncthreads();
#endif
#if PIPE_LEVEL >= 2
    bf16_t* PB = (bf16_t*)(arena + AR_HI);
    {
        const float* pp = p.in[1] + tok0 * 256;
        for (int r = wave; r < TILE; r += 8) {
            const float4 v = *(const float4*)(pp + (size_t)r * 256 + lane * 4);
            *(u32x2*)(PB + (size_t)r * 256 + lane * 4) = (u32x2){pk2(v.x, v.y), pk2(v.z, v.w)};
        }
    }
    __syncthreads();
    bf16_t* PP = (bf16_t*)(arena + AR_PP);
    {
        const bf16_t* WPROJ = (const bf16_t*)(ws + WS_WPROJ);
        for (int nc = 0; nc < 4; ++nc) {
            const int n0 = nc * 256;
            gemm_tile<256, true>(PB, 256, WPROJ + (size_t)n0 * 256, 256, 256, lds, [=](int row, int col, f32x4 v) {
                *(u32x2*)(PP + (size_t)row * 1024 + n0 + col) = (u32x2){pk2(v[0], v[1]), pk2(v[2], v[3])};
            });
        }
    }
    __syncthreads();
    {
        const bf16_t* WGATE = (const bf16_t*)(ws + WS_WGATE);
        for (int nc = 0; nc < 4; ++nc) {
            const int n0 = nc * 256;
            gemm_tile<256, true>(HB, 1024, WGATE + (size_t)n0 * 1024, 1024, 1024, lds, [=](int row, int col, f32x4 v) {
                const float r = rs2[row];
                const u32x2 pv = *(const u32x2*)(PP + (size_t)row * 1024 + n0 + col);
                float4 h = *(const float4*)(OUT + (size_t)row * 1024 + n0 + col);
                h.x += sigmoid_f(v[0] * r) * bflo(pv.x); h.y += sigmoid_f(v[1] * r) * bfhi(pv.x);
                h.z += sigmoid_f(v[2] * r) * bflo(pv.y); h.w += sigmoid_f(v[3] * r) * bfhi(pv.y);
                *(float4*)(OUT + (size_t)row * 1024 + n0 + col) = h;
            });
        }
    }
    __syncthreads();
#endif
    final_rows(p, tok0);
    __syncthreads();
}

__global__ void __launch_bounds__(NTHREADS) fwd_kernel(Params p) {
    __shared__ __attribute__((aligned(16))) unsigned char lds_raw[LDS_BYTES];
    LAS unsigned char* lds = (LAS unsigned char*)lds_raw;
    cg::grid_group grid = cg::this_grid();
    phase0(p, lds);
    grid.sync();
    for (int tile = blockIdx.x; tile < NTILES; tile += gridDim.x) phase1(p, lds, tile);
    grid.sync();
    for (int tile = blockIdx.x; tile < NTILES; tile += gridDim.x) phase2(p, lds, tile);
}

extern "C" void kernel_launch(void* const* d_in, const int* in_sizes, int n_in, void* d_out, int out_size, void* d_ws, size_t ws_size,
                              hipStream_t stream) {
    static int grid_blocks = 0;
    if (!grid_blocks) {
        int dev = 0, cus = 0, per_cu = 0;
        (void)hipGetDevice(&dev);
        (void)hipDeviceGetAttribute(&cus, hipDeviceAttributeMultiprocessorCount, dev);
        (void)hipOccupancyMaxActiveBlocksPerMultiprocessor(&per_cu, fwd_kernel, NTHREADS, 0);
        if (per_cu < 1) { fprintf(stderr, "kernel_launch: occupancy query says %d blocks per CU\n", per_cu); per_cu = 1; }
        grid_blocks = cus * 1;
        if (grid_blocks > NTILES) grid_blocks = NTILES;
        if (ws_size < WS_END) fprintf(stderr, "kernel_launch: workspace too small: %zu < %zu\n", ws_size, (size_t)WS_END);
        fprintf(stderr, "kernel_launch: cus=%d per_cu=%d grid=%d ws=%zu need=%zu\n", cus, per_cu, grid_blocks, ws_size, (size_t)WS_END);
    }
    Params p{};
    for (int i = 0; i < 30; ++i) p.in[i] = (const float*)d_in[i];
    p.out = (float*)d_out;
    p.ws = (unsigned char*)d_ws;
    void* args[] = {&p};
    hipError_t e = hipLaunchCooperativeKernel((void*)fwd_kernel, dim3(grid_blocks), dim3(NTHREADS), args, 0, stream);
    if (e != hipSuccess) fprintf(stderr, "cooperative launch failed: %s (grid %d)\n", hipGetErrorString(e), grid_blocks);
}
```

```cpp
#include <hip/hip_runtime.h>
#include <hip/hip_cooperative_groups.h>
#include <cstdio>
#include <cstdint>
namespace cg = cooperative_groups;


#define LAS __attribute__((address_space(3)))
typedef unsigned short bf16_t;
typedef short bf16x8 __attribute__((ext_vector_type(8)));
typedef float f32x4 __attribute__((ext_vector_type(4)));
typedef float f32x2 __attribute__((ext_vector_type(2)));
typedef unsigned u32x4 __attribute__((ext_vector_type(4)));
typedef unsigned u32x2 __attribute__((ext_vector_type(2)));

constexpr int T_TOK = 16 * 2048, SEQ = 2048, D = 1024, DIN = 1536;
constexpr int NG = 32;
constexpr int TILE = 128, NTILES = T_TOK / TILE, TPS = SEQ / TILE;
constexpr float EPS = 1e-6f;
constexpr int NTHREADS = 512;

constexpr size_t WS_WIN = 0;
constexpr size_t WS_WGLU = WS_WIN + (size_t)1536 * 1024 * 2;
constexpr size_t WS_WOUT = WS_WGLU + (size_t)512 * 512 * 2;
constexpr size_t WS_WQ = WS_WOUT + (size_t)1024 * 1024 * 2;
constexpr size_t WS_KEYS = WS_WQ + (size_t)2048 * 1024 * 2;
constexpr size_t WS_WGATE = WS_KEYS + (size_t)16 * 128 * 128 * 2;
constexpr size_t WS_WPROJ = WS_WGATE + (size_t)1024 * 1024 * 2;
constexpr size_t WS_WSM = WS_WPROJ + (size_t)1024 * 256 * 2;
constexpr size_t WS_TT = WS_WSM + (size_t)4 * 128 * 128 * 2;
constexpr size_t WS_WST = WS_TT + (size_t)32 * 128 * 256 * 2;
constexpr size_t WS_PW = WS_WST + (size_t)32 * 128 * 128 * 2;
constexpr size_t WS_STILE = WS_PW + (size_t)32 * 17 * 128 * 4;
constexpr size_t WS_UTAB = WS_STILE + (size_t)256 * 32 * 128 * 4;
constexpr size_t WS_VTAB = WS_UTAB + (size_t)16384 * 1024;
constexpr size_t WS_RSTD = WS_VTAB + (size_t)16384 * 1024;
constexpr size_t WS_SSQ = WS_RSTD + (size_t)T_TOK * 4;
constexpr size_t WS_BAR = WS_SSQ + (size_t)T_TOK * 8 * 4;
constexpr size_t WS_MIXA = WS_BAR + 16384;
constexpr size_t WS_HB = WS_MIXA + (size_t)T_TOK * 1024 * 2;
constexpr size_t WS_ARENA = WS_HB + (size_t)T_TOK * 1024 * 2;
constexpr size_t AR_XS = 0;
constexpr size_t AR_HLOC = 131072;
constexpr size_t AR_UG = 393216;
constexpr size_t AR_Q = 0;
constexpr size_t AR_PP = 0;
constexpr size_t AR_GV = 524288;
constexpr size_t AR_VNT = 655360;
constexpr size_t AR_HI = 786432;
constexpr size_t ARENA_BYTES = 917504;
constexpr size_t WS_END = WS_ARENA + (size_t)NTILES * ARENA_BYTES;

constexpr int LDS_MISC = 100352;
constexpr int LDS_BYTES = LDS_MISC + 4096;

struct Params {
    const float* in[30];
    float* out;
    unsigned char* ws;
};

__device__ __forceinline__ unsigned f2bf(float f) {
    unsigned u = __float_as_uint(f);
    return (u + 0x7fffu + ((u >> 16) & 1u)) >> 16;
}
__device__ __forceinline__ unsigned pk2(float lo, float hi) { return f2bf(lo) | (f2bf(hi) << 16); }
__device__ __forceinline__ float bflo(unsigned w) { return __uint_as_float(w << 16); }
__device__ __forceinline__ float bfhi(unsigned w) { return __uint_as_float(w & 0xffff0000u); }
__device__ __forceinline__ float bf2f(bf16_t b) { return __uint_as_float((unsigned)b << 16); }
__device__ __forceinline__ float wave_sum(float v) {
#pragma unroll
    for (int o = 1; o < 64; o <<= 1) v += __shfl_xor(v, o);
    return v;
}
__device__ __forceinline__ float gelu_f(float v) {
    const float av = fabsf(v);
    const float t = __builtin_amdgcn_rcpf(av * 0.2316418882f + 1.0f);
    float q = t * 0.5307027145f + (-0.7265760135f);
    q = q * t + 0.7107068705f; q = q * t + (-0.142248368f); q = q * t + 0.127414796f; q = q * t;
    const float e = __builtin_amdgcn_exp2f(v * v * (-0.72134752044f));
    const float m = v * (q * e);
    return v < 0.f ? m : v - m;
}
__device__ __forceinline__ float sigmoid_f(float x) {
    return __builtin_amdgcn_rcpf(1.0f + __builtin_amdgcn_exp2f(x * (-1.44269504089f)));
}
#define LDS_WAIT() asm volatile("s_waitcnt lgkmcnt(0)" ::: "memory")
#ifdef PROBE_A
#define STAMP(i) do { if (threadIdx.x == 0) ((LAS unsigned long long*)(lds + LDS_MISC + 2048))[i] = __builtin_amdgcn_s_memrealtime(); } while (0)
#else
#define STAMP(i) do { } while (0)
#endif

template <int BN, bool TR, class Epi>
__device__ __forceinline__ void gemm_tile(const bf16_t* __restrict__ A, int lda, const bf16_t* __restrict__ Bt, int ldb, int K,
                                          LAS unsigned char* lds, const Epi& epi) {
    constexpr int NT = BN / 64;
    constexpr int BCH = BN / 64;
    constexpr int A_BYTES = 128 * 128;
    constexpr int B_BYTES = BN * 128;
    constexpr int B_OFF = 2 * A_BYTES;
    int tid = threadIdx.x;
    asm volatile("" : "+v"(tid));
    const int lane = tid & 63, wave = tid >> 6, wm = wave >> 2, wn = wave & 3;
    const int lrow = tid >> 3, lch = tid & 7;
    const int st_off = lrow * 128 + ((lch ^ ((lrow >> 1) & 7)) << 4);
    f32x4 acc[4][NT];
#pragma unroll
    for (int i = 0; i < 4; ++i)
#pragma unroll
        for (int j = 0; j < NT; ++j) acc[i][j] = (f32x4){0.f, 0.f, 0.f, 0.f};
    const bf16_t* ap = A + (size_t)lrow * lda + lch * 8;
    const bf16_t* bp = Bt + (size_t)lrow * ldb + lch * 8;
    u32x4 ra[2], rb[BCH];
#pragma unroll
    for (int i = 0; i < 2; ++i) ra[i] = *(const u32x4*)(ap + (size_t)(64 * i) * lda);
#pragma unroll
    for (int i = 0; i < BCH; ++i) rb[i] = *(const u32x4*)(bp + (size_t)(64 * i) * ldb);
#pragma unroll
    for (int i = 0; i < 2; ++i) *(LAS u32x4*)(lds + st_off + i * 64 * 128) = ra[i];
#pragma unroll
    for (int i = 0; i < BCH; ++i) *(LAS u32x4*)(lds + B_OFF + st_off + i * 64 * 128) = rb[i];
    __syncthreads();
    const int KT = K / 64;
    const int fr = lane & 15, fq = lane >> 4;
    const int fsw = (lane >> 1) & 7;
    for (int kt = 0; kt < KT; ++kt) {
        const int cur = kt & 1;
        if (kt + 1 < KT) {
            const int k0 = (kt + 1) * 64;
#pragma unroll
            for (int i = 0; i < 2; ++i) ra[i] = *(const u32x4*)(ap + (size_t)(64 * i) * lda + k0);
#pragma unroll
            for (int i = 0; i < BCH; ++i) rb[i] = *(const u32x4*)(bp + (size_t)(64 * i) * ldb + k0);
        }
        LAS unsigned char* la = lds + cur * A_BYTES + (wm * 64 + fr) * 128;
        LAS unsigned char* lb = lds + B_OFF + cur * B_BYTES + (wn * (BN / 4) + fr) * 128;
#pragma unroll
        for (int kk = 0; kk < 2; ++kk) {
            const int choff = ((kk * 4 + fq) ^ fsw) << 4;
            bf16x8 af[4], bfr[NT];
#pragma unroll
            for (int i = 0; i < 4; ++i) af[i] = *(LAS bf16x8*)(la + i * 16 * 128 + choff);
#pragma unroll
            for (int j = 0; j < NT; ++j) bfr[j] = *(LAS bf16x8*)(lb + j * 16 * 128 + choff);
#pragma unroll
            for (int i = 0; i < 4; ++i)
#pragma unroll
                for (int j = 0; j < NT; ++j) {
                    if (TR) acc[i][j] = __builtin_amdgcn_mfma_f32_16x16x32_bf16(bfr[j], af[i], acc[i][j], 0, 0, 0);
                    else    acc[i][j] = __builtin_amdgcn_mfma_f32_16x16x32_bf16(af[i], bfr[j], acc[i][j], 0, 0, 0);
                }
        }
        if (kt + 1 < KT) {
            const int nxt = cur ^ 1;
#pragma unroll
            for (int i = 0; i < 2; ++i) *(LAS u32x4*)(lds + nxt * A_BYTES + st_off + i * 64 * 128) = ra[i];
#pragma unroll
            for (int i = 0; i < BCH; ++i) *(LAS u32x4*)(lds + B_OFF + nxt * B_BYTES + st_off + i * 64 * 128) = rb[i];
        }
        __syncthreads();
    }
#pragma unroll
    for (int i = 0; i < 4; ++i)
#pragma unroll
        for (int j = 0; j < NT; ++j) {
            if (TR) epi(wm * 64 + i * 16 + fr, wn * (BN / 4) + j * 16 + 4 * fq, acc[i][j]);
            else    epi(wm * 64 + i * 16 + 4 * fq, wn * (BN / 4) + j * 16 + fr, acc[i][j]);
        }
}

__device__ __forceinline__ void transpose_item(const float* __restrict__ W, int K, int N, bf16_t* __restrict__ WT,
                                               const float* __restrict__ g1, const float* __restrict__ g2, int split,
                                               LAS float* scr, int item, int lane) {
    const int nblk = N / 32, kb = item / nblk, nb = item % nblk, k0 = 64 * kb, n0 = 32 * nb;
#pragma unroll 8
    for (int i = 0; i < 32; ++i) {
        const int kk = 2 * i + (lane >> 5), k = k0 + kk;
        float w = W[(size_t)k * N + n0 + (lane & 31)];
        if (g1) w *= (k < split) ? g1[k] : g2[k - split];
        scr[kk * 33 + (lane & 31)] = w;
    }
    LDS_WAIT();
    const int c = lane & 7;
#pragma unroll
    for (int j = 0; j < 4; ++j) {
        const int n = (lane >> 3) + 8 * j;
        const LAS float* s = scr + (8 * c) * 33 + n;
        u32x4 o;
        o.x = pk2(s[0 * 33], s[1 * 33]); o.y = pk2(s[2 * 33], s[3 * 33]);
        o.z = pk2(s[4 * 33], s[5 * 33]); o.w = pk2(s[6 * 33], s[7 * 33]);
        *(u32x4*)(WT + (size_t)(n0 + n) * K + k0 + 8 * c) = o;
    }
    LDS_WAIT();
}

__device__ __forceinline__ void s5_tables(const Params& p, LAS unsigned char* lds, int g) {
    const int tid = threadIdx.x;
    LAS float* apr = (LAS float*)lds;
    LAS float* api = apr + 9 * 64;
    LAS float* bbr = api + 9 * 64;
    LAS float* bbi = bbr + 1024;
    LAS float* ccr = bbi + 1024;
    LAS float* cci = ccr + 1024;
    LAS float* kk = cci + 1024;
    const float* a_re = p.in[4]; const float* a_im = p.in[5]; const float* log_dt = p.in[6];
    const float* b_re = p.in[7]; const float* b_im = p.in[8]; const float* c_re = p.in[9]; const float* c_im = p.in[10];
    const float* dsk = p.in[11];
    float* PW = (float*)(p.ws + WS_PW) + (size_t)g * 17 * 128;
    bf16_t* TT = (bf16_t*)(p.ws + WS_TT) + (size_t)g * 128 * 256;
    bf16_t* WST = (bf16_t*)(p.ws + WS_WST) + (size_t)g * 128 * 128;
    if (tid < 64) {
        const int n = tid;
        const float lr = a_re[g * 64 + n], li = a_im[g * 64 + n], dt = expf(log_dt[g]);
        const float mag = expf(lr * dt), ang = li * dt;
        float rev = ang * 0.15915494309189535f;
        rev = rev - floorf(rev);
        const float ar = mag * __builtin_amdgcn_cosf(rev), ai = mag * __builtin_amdgcn_sinf(rev);
        float pr = 1.f, pi = 0.f;
        apr[n] = pr; api[n] = pi;
        for (int k = 1; k <= 8; ++k) {
            const float nr = pr * ar - pi * ai, ni = pr * ai + pi * ar;
            pr = nr; pi = ni; apr[k * 64 + n] = pr; api[k * 64 + n] = pi;
        }
        const float a8r = pr, a8i = pi;
        float qr = 1.f, qi = 0.f;
        for (int c = 0; c <= 16; ++c) {
            PW[c * 128 + n] = qr; PW[c * 128 + 64 + n] = qi;
            const float nr = qr * a8r - qi * a8i, ni = qr * a8i + qi * a8r;
            qr = nr; qi = ni;
        }
        const float nr = ar - 1.0f, ni = ai, den = lr * lr + li * li;
        const float cr = (nr * lr + ni * li) / den, ci = (ni * lr - nr * li) / den;
        for (int c2 = 0; c2 < 16; ++c2) {
            const float br = b_re[(size_t)(g * 64 + n) * 16 + c2], bi = b_im[(size_t)(g * 64 + n) * 16 + c2];
            bbr[n * 16 + c2] = cr * br - ci * bi;
            bbi[n * 16 + c2] = cr * bi + ci * br;
        }
    }
    for (int i = tid; i < 1024; i += NTHREADS) { ccr[i] = c_re[(size_t)g * 1024 + i]; cci[i] = c_im[(size_t)g * 1024 + i]; }
    __syncthreads();
    for (int e = tid; e < 2048; e += NTHREADS) {
        const int k = e >> 8, c = (e >> 4) & 15, c2 = e & 15;
        float s = 0.f;
        for (int n = 0; n < 64; ++n) {
            const float pr = apr[k * 64 + n], pi = api[k * 64 + n], br = bbr[n * 16 + c2], bi = bbi[n * 16 + c2];
            const float tr = pr * br - pi * bi, ti = pr * bi + pi * br;
            s += ccr[c * 64 + n] * tr - cci[c * 64 + n] * ti;
        }
        if (k == 0 && c == c2) s += dsk[g * 16 + c];
        kk[e] = s;
    }
    __syncthreads();
    for (int e = tid; e < 128 * 256; e += NTHREADS) {
        const int row = e >> 8, col = e & 255, tau = row >> 4, c = row & 15;
        float v;
        if (col < 128) {
            const int sg = col >> 4, c2 = col & 15;
            v = (tau >= sg) ? kk[((tau - sg) << 8) + (c << 4) + c2] : 0.f;
        } else {
            const int n = col & 63;
            const float pr = apr[(tau + 1) * 64 + n], pi = api[(tau + 1) * 64 + n];
            const float cr = ccr[c * 64 + n], ci = cci[c * 64 + n];
            v = (col < 192) ? (cr * pr - ci * pi) : -(cr * pi + ci * pr);
        }
        TT[e] = (bf16_t)f2bf(v);
    }
    for (int e = tid; e < 128 * 128; e += NTHREADS) {
        const int row = e >> 7, col = e & 127, part = row >> 6, n = row & 63, sg = col >> 4, c2 = col & 15;
        const float pr = apr[(7 - sg) * 64 + n], pi = api[(7 - sg) * 64 + n], br = bbr[n * 16 + c2], bi = bbi[n * 16 + c2];
        const float v = part ? (pr * bi + pi * br) : (pr * br - pi * bi);
        WST[e] = (bf16_t)f2bf(v);
    }
    __syncthreads();
}

__device__ __forceinline__ void phase0(const Params& p, LAS unsigned char* lds) {
    const int tid = threadIdx.x, lane = tid & 63, wave = tid >> 6;
    unsigned char* ws = p.ws;
    for (int g = blockIdx.x; g < NG; g += gridDim.x) s5_tables(p, lds, g);
    {
        LAS float* scr = (LAS float*)(lds + wave * 8448);
        const int gw = blockIdx.x * 8 + wave, ngw = gridDim.x * 8;
        constexpr int I0 = 16 * 48, I1 = 8 * 16, I2 = 16 * 32, I3 = 16 * 64, I4 = 16 * 32, I5 = 4 * 32;
        for (int it = gw; it < I0 + I1 + I2 + I3 + I4 + I5; it += ngw) {
            int r = it;
            if (r < I0) { transpose_item(p.in[3], 1024, 1536, (bf16_t*)(ws + WS_WIN), p.in[2], p.in[2], 1024, scr, r, lane); continue; } r -= I0;
            if (r < I1) { transpose_item(p.in[12], 512, 512, (bf16_t*)(ws + WS_WGLU), nullptr, nullptr, 0, scr, r, lane); continue; } r -= I1;
            if (r < I2) { transpose_item(p.in[20], 1024, 1024, (bf16_t*)(ws + WS_WOUT), p.in[18], p.in[19], 512, scr, r, lane); continue; } r -= I2;
            if (r < I3) { transpose_item(p.in[22], 1024, 2048, (bf16_t*)(ws + WS_WQ), p.in[21], p.in[21], 1024, scr, r, lane); continue; } r -= I3;
            if (r < I4) { transpose_item(p.in[27], 1024, 1024, (bf16_t*)(ws + WS_WGATE), p.in[26], p.in[26], 1024, scr, r, lane); continue; } r -= I4;
            transpose_item(p.in[28], 256, 1024, (bf16_t*)(ws + WS_WPROJ), nullptr, nullptr, 0, scr, r, lane);
        }
    }
    const size_t gt = (size_t)blockIdx.x * NTHREADS + tid, ngt = (size_t)gridDim.x * NTHREADS;
    {
        const float4* src = (const float4*)p.in[23]; u32x2* dst = (u32x2*)(ws + WS_KEYS);
        for (size_t i = gt; i < 65536; i += ngt) { const float4 v = src[i]; dst[i] = (u32x2){pk2(v.x, v.y), pk2(v.z, v.w)}; }
    }
    {
        const float4* src = (const float4*)p.in[16]; u32x2* dst = (u32x2*)(ws + WS_WSM);
        for (size_t i = gt; i < 16384; i += ngt) {
            float4 v = src[i];
            const int t = (int)((i >> 5) & 127), s0 = (int)(i & 31) * 4;
            if (s0 + 0 > t) v.x = 0.f; if (s0 + 1 > t) v.y = 0.f; if (s0 + 2 > t) v.z = 0.f; if (s0 + 3 > t) v.w = 0.f;
            dst[i] = (u32x2){pk2(v.x, v.y), pk2(v.z, v.w)};
        }
    }
    {
        const float4* su = (const float4*)p.in[24]; const float4* sv = (const float4*)p.in[25];
        const float4* g4 = (const float4*)p.in[21];
        unsigned* du = (unsigned*)(ws + WS_UTAB); unsigned* dv = (unsigned*)(ws + WS_VTAB);
        for (size_t i = gt; i < (size_t)16384 * 256; i += ngt) {
            float4 v = su[i]; const float4 g = g4[i & 255];
            int w = __builtin_amdgcn_cvt_pk_fp8_f32(v.x * g.x * 64.f, v.y * g.y * 64.f, 0, false);
            w = __builtin_amdgcn_cvt_pk_fp8_f32(v.z * g.z * 64.f, v.w * g.w * 64.f, w, true);
            du[i] = (unsigned)w;
            v = sv[i];
            w = __builtin_amdgcn_cvt_pk_fp8_f32(v.x * 4.f, v.y * 4.f, 0, false);
            w = __builtin_amdgcn_cvt_pk_fp8_f32(v.z * 4.f, v.w * 4.f, w, true);
            dv[i] = (unsigned)w;
        }
    }
}

__device__ __forceinline__ void phase1(const Params& p, LAS unsigned char* lds, int tile) {
    int tid = threadIdx.x;
    asm volatile("" : "+v"(tid));
    const int lane = tid & 63, wave = tid >> 6;
    unsigned char* ws = p.ws;
    const size_t tok0 = (size_t)tile * TILE;
    unsigned char* arena = ws + WS_ARENA + (size_t)tile * ARENA_BYTES;
    bf16_t* XB = (bf16_t*)(ws + WS_HB) + tok0 * 1024;
    bf16_t* XS = (bf16_t*)(arena + AR_XS);
    bf16_t* UG = (bf16_t*)(arena + AR_UG);
    bf16_t* GVT = (bf16_t*)(arena + AR_GV);
    float* HLOC = (float*)(arena + AR_HLOC);
    bf16_t* MIXA = (bf16_t*)(ws + WS_MIXA) + tok0 * 1024;
    LAS float* rs = (LAS float*)(lds + LDS_MISC);
    const float* x = p.in[0];

    for (int r = wave; r < TILE; r += 8) {
        const float4* xr = (const float4*)(x + (tok0 + r) * 1024);
        float ss = 0.f;
#pragma unroll
        for (int j = 0; j < 2; ++j) {
            const float4 a = xr[lane * 2 + 128 * j], b = xr[lane * 2 + 1 + 128 * j];
            ss += a.x * a.x + a.y * a.y + a.z * a.z + a.w * a.w + b.x * b.x + b.y * b.y + b.z * b.z + b.w * b.w;
            *(u32x4*)(XB + (size_t)r * 1024 + lane * 8 + 512 * j) = (u32x4){pk2(a.x, a.y), pk2(a.z, a.w), pk2(b.x, b.y), pk2(b.z, b.w)};
        }
        ss = wave_sum(ss);
        if (lane == 0) rs[r] = rsqrtf(ss * (1.0f / 1024.0f) + EPS);
    }
    __syncthreads();

    const bf16_t* WIN = (const bf16_t*)(ws + WS_WIN);
    for (int nc = 0; nc < 2; ++nc) {
        const int n0 = nc * 256;
        gemm_tile<256, true>(XB, 1024, WIN + (size_t)n0 * 1024, 1024, 1024, lds, [=](int row, int col, f32x4 v) {
            const float r = rs[row];
            const int gc = n0 + col, g = gc >> 4, c0 = gc & 15;
            *(u32x2*)(XS + ((size_t)g * 128 + row) * 16 + c0) = (u32x2){pk2(v[0] * r, v[1] * r), pk2(v[2] * r, v[3] * r)};
        });
    }
    for (int nc = 2; nc < 4; ++nc) {
        const int n0 = nc * 256;
        gemm_tile<256, true>(XB, 1024, WIN + (size_t)n0 * 1024, 1024, 1024, lds, [=](int row, int col, f32x4 v) {
            const float r = rs[row];
            const int gc = n0 + col - 512;
            *(u32x2*)(UG + (size_t)row * 512 + gc) = (u32x2){pk2(gelu_f(v[0] * r), gelu_f(v[1] * r)), pk2(gelu_f(v[2] * r), gelu_f(v[3] * r))};
        });
    }
    for (int nc = 4; nc < 6; ++nc) {
        const int n0 = nc * 256;
        gemm_tile<256, false>(XB, 1024, WIN + (size_t)n0 * 1024, 1024, 1024, lds, [=](int row, int col, f32x4 v) {
            const int gc = n0 + col - 1024;
            *(u32x2*)(GVT + (size_t)gc * 128 + row) = (u32x2){pk2(gelu_f(v[0] * rs[row]), gelu_f(v[1] * rs[row + 1])),
                                                              pk2(gelu_f(v[2] * rs[row + 2]), gelu_f(v[3] * rs[row + 3]))};
        });
    }
    __syncthreads();

    LAS float* stat = (LAS float*)lds;
    {
        const int s = tid & 127, head = tid >> 7;
        float sum = 0.f, sq = 0.f;
        for (int d = 0; d < 128; ++d) { const float v = bf2f(GVT[(size_t)(head * 128 + d) * 128 + s]); sum += v; sq += v * v; }
        const float mu = sum * (1.0f / 128.0f), var = sq * (1.0f / 128.0f) - mu * mu;
        stat[(head * 128 + s) * 2] = mu; stat[(head * 128 + s) * 2 + 1] = rsqrtf(fmaxf(var, 0.f) + EPS);
    }
    __syncthreads();
    {
        const float* lng = p.in[14]; const float* lnb = p.in[15];
        for (int c = tid; c < 8192; c += NTHREADS) {
            const int hd = c >> 4, s0 = (c & 15) * 8, head = hd >> 7;
            u32x4 w = *(u32x4*)(GVT + (size_t)hd * 128 + s0);
            const float g = lng[hd], b = lnb[hd];
            float o[8];
            const unsigned ww[4] = {w.x, w.y, w.z, w.w};
#pragma unroll
            for (int i = 0; i < 4; ++i) {
                const float mu0 = stat[(head * 128 + s0 + 2 * i) * 2], r0 = stat[(head * 128 + s0 + 2 * i) * 2 + 1];
                const float mu1 = stat[(head * 128 + s0 + 2 * i + 1) * 2], r1 = stat[(head * 128 + s0 + 2 * i + 1) * 2 + 1];
                o[2 * i] = (bflo(ww[i]) - mu0) * r0 * g + b;
                o[2 * i + 1] = (bfhi(ww[i]) - mu1) * r1 * g + b;
            }
            *(u32x4*)(GVT + (size_t)hd * 128 + s0) = (u32x4){pk2(o[0], o[1]), pk2(o[2], o[3]), pk2(o[4], o[5]), pk2(o[6], o[7])};
        }
    }
    __syncthreads();

    {
        const bf16_t* WSM = (const bf16_t*)(ws + WS_WSM);
        const float* bs = p.in[17];
        for (int head = 0; head < 4; ++head) {
            gemm_tile<128, true>(WSM + (size_t)head * 16384, 128, GVT + (size_t)head * 16384, 128, 128, lds, [=](int row, int col, f32x4 v) {
                const float b = bs[head * 128 + row];
                const u32x2 uu = *(const u32x2*)(UG + (size_t)row * 512 + head * 128 + col);
                const float y0 = bflo(uu.x) * (v[0] + b), y1 = bfhi(uu.x) * (v[1] + b), y2 = bflo(uu.y) * (v[2] + b), y3 = bfhi(uu.y) * (v[3] + b);
                *(u32x2*)(MIXA + (size_t)row * 1024 + 512 + head * 128 + col) = (u32x2){pk2(y0, y1), pk2(y2, y3)};
            });
        }
    }
    __syncthreads();
    for (int r = wave; r < TILE; r += 8) {
        bf16_t* yr = MIXA + (size_t)r * 1024 + 512 + lane * 8;
        const u32x4 w = *(u32x4*)yr;
        float f[8] = {bflo(w.x), bfhi(w.x), bflo(w.y), bfhi(w.y), bflo(w.z), bfhi(w.z), bflo(w.w), bfhi(w.w)};
        float ss = 0.f;
#pragma unroll
        for (int i = 0; i < 8; ++i) ss += f[i] * f[i];
        ss = wave_sum(ss);
        const float rr = rsqrtf(ss * (1.0f / 512.0f) + EPS);
        *(u32x4*)yr = (u32x4){pk2(f[0] * rr, f[1] * rr), pk2(f[2] * rr, f[3] * rr), pk2(f[4] * rr, f[5] * rr), pk2(f[6] * rr, f[7] * rr)};
    }
    {
        const bf16_t* WSTb = (const bf16_t*)(ws + WS_WST);
        const float* PW = (const float*)(ws + WS_PW);
        float* STILE = (float*)(ws + WS_STILE) + (size_t)tile * NG * 128;
        LAS float* sl = (LAS float*)(lds + wave * 8192);
        const int fr = lane & 15, fq = lane >> 4;
        for (int g = wave; g < NG; g += 8) {
            f32x4 acc[8];
#pragma unroll
            for (int j = 0; j < 8; ++j) acc[j] = (f32x4){0.f, 0.f, 0.f, 0.f};
            const bf16_t* abase = XS + (size_t)g * 2048 + fr * 128 + fq * 8;
            const bf16_t* bbase = WSTb + (size_t)g * 16384 + (size_t)fr * 128 + fq * 8;
#pragma unroll
            for (int ks = 0; ks < 4; ++ks) {
                const bf16x8 af = *(const bf16x8*)(abase + ks * 32);
#pragma unroll
                for (int j = 0; j < 8; ++j) {
                    const bf16x8 bfr = *(const bf16x8*)(bbase + (size_t)j * 16 * 128 + ks * 32);
                    acc[j] = __builtin_amdgcn_mfma_f32_16x16x32_bf16(bfr, af, acc[j], 0, 0, 0);
                }
            }
#pragma unroll
            for (int j = 0; j < 8; ++j) *(LAS f32x4*)(sl + fr * 128 + 16 * j + 4 * fq) = acc[j];
            LDS_WAIT();
            const float a8r = PW[(size_t)g * 17 * 128 + 128 + lane], a8i = PW[(size_t)g * 17 * 128 + 128 + 64 + lane];
            float hr = 0.f, hi = 0.f;
            for (int c = 0; c < 16; ++c) {
                HLOC[((size_t)g * 16 + c) * 128 + lane] = hr; HLOC[((size_t)g * 16 + c) * 128 + 64 + lane] = hi;
                const float sr = sl[c * 128 + lane], si = sl[c * 128 + 64 + lane];
                const float nr = a8r * hr - a8i * hi + sr, ni = a8r * hi + a8i * hr + si;
                hr = nr; hi = ni;
            }
            STILE[(size_t)g * 128 + lane] = hr; STILE[(size_t)g * 128 + 64 + lane] = hi;
            LDS_WAIT();
        }
    }
    __syncthreads();
}

__device__ __forceinline__ void final_rows(const Params& p, size_t tok0) {
    const int lane = threadIdx.x & 63, wave = threadIdx.x >> 6;
    const float4* g4 = (const float4*)p.in[29];
    for (int r = wave; r < TILE; r += 8) {
        float4* hr = (float4*)(p.out + (tok0 + r) * 1024);
        float4 v[4]; float ss = 0.f;
#pragma unroll
        for (int j = 0; j < 4; ++j) { v[j] = hr[lane + 64 * j]; ss += v[j].x * v[j].x + v[j].y * v[j].y + v[j].z * v[j].z + v[j].w * v[j].w; }
        ss = wave_sum(ss);
        const float rr = rsqrtf(ss * (1.0f / 1024.0f) + EPS);
#pragma unroll
        for (int j = 0; j < 4; ++j) {
            const float4 g = g4[lane + 64 * j];
            v[j].x *= rr * g.x; v[j].y *= rr * g.y; v[j].z *= rr * g.z; v[j].w *= rr * g.w;
            hr[lane + 64 * j] = v[j];
        }
    }
}

__device__ __forceinline__ unsigned ord_key(float f) { const unsigned u = __float_as_uint(f); return (u & 0x80000000u) ? ~u : (u | 0x80000000u); }
__device__ __forceinline__ float ord_val(unsigned k) { return (k & 0x80000000u) ? __uint_as_float(k & 0x7fffffffu) : __uint_as_float(~k); }

__device__ __forceinline__ void phase2(const Params& p, LAS unsigned char* lds, int tile) {
    int tid = threadIdx.x;
    asm volatile("" : "+v"(tid));
    const int lane = tid & 63, wave = tid >> 6;
    unsigned char* ws = p.ws;
    const size_t tok0 = (size_t)tile * TILE;
    unsigned char* arena = ws + WS_ARENA + (size_t)tile * ARENA_BYTES;
    bf16_t* HB = (bf16_t*)(ws + WS_HB) + tok0 * 1024;
    bf16_t* XS = (bf16_t*)(arena + AR_XS);
    float* HLOC = (float*)(arena + AR_HLOC);
    bf16_t* HI = (bf16_t*)(arena + AR_HI);
    bf16_t* YS = (bf16_t*)(arena + AR_GV);
    bf16_t* MIXA = (bf16_t*)(ws + WS_MIXA) + tok0 * 1024;
    float* OUT = p.out + tok0 * 1024;
    const float* x = p.in[0] + tok0 * 1024;
    LAS float* rs = (LAS float*)(lds + LDS_MISC);
    LAS float* rs2 = (LAS float*)(lds + LDS_MISC + 512);
    const float* PW = (const float*)(ws + WS_PW);

    {
        const int ti = tile & (TPS - 1);
        const float* STILE = (const float*)(ws + WS_STILE) + (size_t)(tile - ti) * NG * 128;
        for (int idx = tid; idx < NG * 64; idx += NTHREADS) {
            const int g = idx >> 6, n = idx & 63;
            const float* pw = PW + (size_t)g * 17 * 128;
            const float ar = pw[16 * 128 + n], ai = pw[16 * 128 + 64 + n];
            float hr = 0.f, hi = 0.f;
            for (int j = 0; j < ti; ++j) {
                const float sr = STILE[((size_t)j * NG + g) * 128 + n], si = STILE[((size_t)j * NG + g) * 128 + 64 + n];
                const float nr = ar * hr - ai * hi + sr, ni = ar * hi + ai * hr + si;
                hr = nr; hi = ni;
            }
            for (int c = 0; c < 16; ++c) {
                const float qr = pw[c * 128 + n], qi = pw[c * 128 + 64 + n];
                const float vr = qr * hr - qi * hi + HLOC[((size_t)g * 16 + c) * 128 + n];
                const float vi = qr * hi + qi * hr + HLOC[((size_t)g * 16 + c) * 128 + 64 + n];
                HI[((size_t)g * 16 + c) * 128 + n] = (bf16_t)f2bf(vr);
                HI[((size_t)g * 16 + c) * 128 + 64 + n] = (bf16_t)f2bf(vi);
            }
        }
    }
    __syncthreads();
    {
        const bf16_t* TTb = (const bf16_t*)(ws + WS_TT);
        const int fr = lane & 15, fq = lane >> 4;
        for (int g = wave; g < NG; g += 8) {
            f32x4 acc[8];
#pragma unroll
            for (int j = 0; j < 8; ++j) acc[j] = (f32x4){0.f, 0.f, 0.f, 0.f};
            const bf16_t* a0 = XS + (size_t)g * 2048 + fr * 128 + fq * 8;
            const bf16_t* a1 = HI + (size_t)g * 2048 + fr * 128 + fq * 8;
            const bf16_t* bbase = TTb + (size_t)g * 32768 + (size_t)fr * 256 + fq * 8;
#pragma unroll
            for (int ks = 0; ks < 8; ++ks) {
                const bf16x8 af = (ks < 4) ? *(const bf16x8*)(a0 + ks * 32) : *(const bf16x8*)(a1 + (ks - 4) * 32);
#pragma unroll
                for (int j = 0; j < 8; ++j) {
                    const bf16x8 bfr = *(const bf16x8*)(bbase + (size_t)j * 16 * 256 + ks * 32);
                    acc[j] = __builtin_amdgcn_mfma_f32_16x16x32_bf16(bfr, af, acc[j], 0, 0, 0);
                }
            }
#pragma unroll
            for (int j = 0; j < 8; ++j) {
                const f32x4 v = acc[j];
                *(u32x2*)(YS + (size_t)(fr * 8 + j) * 512 + g * 16 + 4 * fq) = (u32x2){pk2(gelu_f(v[0]), gelu_f(v[1])), pk2(gelu_f(v[2]), gelu_f(v[3]))};
            }
        }
    }
    __syncthreads();
    {
        const bf16_t* WGLU = (const bf16_t*)(ws + WS_WGLU);
        const float* gb = p.in[13];
        for (int nc = 0; nc < 2; ++nc) {
            const int n0 = nc * 256;
            gemm_tile<256, true>(YS, 512, WGLU + (size_t)n0 * 512, 512, 512, lds, [=](int row, int col, f32x4 v) {
                const int gc = n0 + col;
                const u32x2 yy = *(const u32x2*)(YS + (size_t)row * 512 + gc);
                const float4 b = *(const float4*)(gb + gc);
                const float y0 = bflo(yy.x) * sigmoid_f(v[0] + b.x), y1 = bfhi(yy.x) * sigmoid_f(v[1] + b.y);
                const float y2 = bflo(yy.y) * sigmoid_f(v[2] + b.z), y3 = bfhi(yy.y) * sigmoid_f(v[3] + b.w);
                *(u32x2*)(MIXA + (size_t)row * 1024 + gc) = (u32x2){pk2(y0, y1), pk2(y2, y3)};
            });
        }
    }
    __syncthreads();
    for (int r = wave; r < TILE; r += 8) {
        bf16_t* yr = MIXA + (size_t)r * 1024 + lane * 8;
        const u32x4 w = *(u32x4*)yr;
        float f[8] = {bflo(w.x), bfhi(w.x), bflo(w.y), bfhi(w.y), bflo(w.z), bfhi(w.z), bflo(w.w), bfhi(w.w)};
        float ss = 0.f;
#pragma unroll
        for (int i = 0; i < 8; ++i) ss += f[i] * f[i];
        ss = wave_sum(ss);
        const float rr = rsqrtf(ss * (1.0f / 512.0f) + EPS);
        *(u32x4*)yr = (u32x4){pk2(f[0] * rr, f[1] * rr), pk2(f[2] * rr, f[3] * rr), pk2(f[4] * rr, f[5] * rr), pk2(f[6] * rr, f[7] * rr)};
    }
    __syncthreads();
    {
        const bf16_t* WOUT = (const bf16_t*)(ws + WS_WOUT);
        for (int nc = 0; nc < 4; ++nc) {
            const int n0 = nc * 256;
            gemm_tile<256, true>(MIXA, 1024, WOUT + (size_t)n0 * 1024, 1024, 1024, lds, [=](int row, int col, f32x4 v) {
                const float4 xx = *(const float4*)(x + (size_t)row * 1024 + n0 + col);
                *(float4*)(OUT + (size_t)row * 1024 + n0 + col) = make_float4(xx.x + v[0], xx.y + v[1], xx.z + v[2], xx.w + v[3]);
            });
        }
    }
    __syncthreads();
    STAMP(5);
    for (int r = wave; r < TILE; r += 8) {
        const float4* hr = (const float4*)(OUT + (size_t)r * 1024);
        float ss = 0.f;
#pragma unroll
        for (int j = 0; j < 2; ++j) {
            const float4 a = hr[lane * 2 + 128 * j], b = hr[lane * 2 + 1 + 128 * j];
            ss += a.x * a.x + a.y * a.y + a.z * a.z + a.w * a.w + b.x * b.x + b.y * b.y + b.z * b.z + b.w * b.w;
            *(u32x4*)(HB + (size_t)r * 1024 + lane * 8 + 512 * j) = (u32x4){pk2(a.x, a.y), pk2(a.z, a.w), pk2(b.x, b.y), pk2(b.z, b.w)};
        }
        ss = wave_sum(ss);
        if (lane == 0) rs[r] = rsqrtf(ss * (1.0f / 1024.0f) + EPS);
    }
    __syncthreads();
    bf16_t* Q = (bf16_t*)(arena + AR_Q);
    {
        const bf16_t* WQ = (const bf16_t*)(ws + WS_WQ);
        for (int nc = 0; nc < 8; ++nc) {
            const int n0 = nc * 256;
            gemm_tile<256, true>(HB, 1024, WQ + (size_t)n0 * 1024, 1024, 1024, lds, [=](int row, int col, f32x4 v) {
                const float r = rs[row];
                *(u32x2*)(Q + (size_t)row * 2048 + n0 + col) = (u32x2){pk2(v[0] * r, v[1] * r), pk2(v[2] * r, v[3] * r)};
            });
        }
    }
    __syncthreads();
    STAMP(6);
    unsigned* TOPK = (unsigned*)(arena + AR_GV);
    {
        const bf16_t* KEYS = (const bf16_t*)(ws + WS_KEYS);
        LAS float* sc = (LAS float*)lds;
        LAS unsigned* lst = (LAS unsigned*)(lds + 66048);
        for (int combo = 0; combo < 16; ++combo) {
            gemm_tile<128, true>(Q + combo * 128, 2048, KEYS + (size_t)combo * 16384, 128, 128, lds, [=](int row, int col, f32x4 v) {
                sc[row * 129 + col] = v[0]; sc[row * 129 + col + 1] = v[1]; sc[row * 129 + col + 2] = v[2]; sc[row * 129 + col + 3] = v[3];
            });
            __syncthreads();
            {
                const int row = tid >> 2, q4 = tid & 3;
                unsigned l[16];
#pragma unroll
                for (int j = 0; j < 16; ++j) l[j] = 0u;
                for (int i = 0; i < 32; ++i) {
                    const int n = q4 * 32 + i;
                    unsigned xk = (ord_key(sc[row * 129 + n]) & 0xFFFFFF80u) | (unsigned)(127 - n);
#pragma unroll
                    for (int j = 0; j < 16; ++j) { const unsigned hi = max(l[j], xk); xk = min(l[j], xk); l[j] = hi; }
                }
#pragma unroll
                for (int j = 0; j < 16; ++j) lst[(row * 4 + q4) * 16 + j] = l[j];
            }
            __syncthreads();
            if (tid < 128) {
                const int row = tid;
                int p0 = 0, p1 = 0, p2 = 0, p3 = 0;
                LAS unsigned* b = lst + row * 64;
                for (int j = 0; j < 16; ++j) {
                    const unsigned k0 = p0 < 16 ? b[p0] : 0u, k1 = p1 < 16 ? b[16 + p1] : 0u, k2 = p2 < 16 ? b[32 + p2] : 0u, k3 = p3 < 16 ? b[48 + p3] : 0u;
                    const unsigned m = max(max(k0, k1), max(k2, k3));
                    if (m == k0) ++p0; else if (m == k1) ++p1; else if (m == k2) ++p2; else ++p3;
                    TOPK[((size_t)row * 16 + combo) * 16 + j] = m;
                }
            }
            __syncthreads();
        }
    }
    STAMP(7);
    int* EIDX = (int*)(arena + AR_VNT);
    float* EGATE = (float*)(arena + AR_VNT + 65536);
    for (int pr = tid; pr < 128 * 8; pr += NTHREADS) {
        const int row = pr >> 3, h = pr & 7;
        const unsigned* k1 = TOPK + ((size_t)row * 16 + h * 2) * 16;
        const unsigned* k2 = k1 + 16;
        float s1[16], s2[16];
#pragma unroll
        for (int j = 0; j < 16; ++j) { s1[j] = ord_val(k1[j] & 0xFFFFFF80u); s2[j] = ord_val(k2[j] & 0xFFFFFF80u); }
        unsigned l[16];
#pragma unroll
        for (int j = 0; j < 16; ++j) l[j] = 0u;
#pragma unroll
        for (int a = 0; a < 16; ++a)
#pragma unroll
            for (int b = 0; b < 16; ++b)
                if ((a + 1) * (b + 1) <= 16) {
                    unsigned xk = (ord_key(s1[a] + s2[b]) & 0xFFFFFF00u) | (unsigned)(255 - (a * 16 + b));
#pragma unroll
                    for (int j = 0; j < 16; ++j) { const unsigned hi = max(l[j], xk); xk = min(l[j], xk); l[j] = hi; }
                }
        float ev[16]; float mx = ord_val(l[0] & 0xFFFFFF00u), sum = 0.f;
#pragma unroll
        for (int j = 0; j < 16; ++j) { ev[j] = __expf(ord_val(l[j] & 0xFFFFFF00u) - mx); sum += ev[j]; }
        const float inv = 1.0f / sum;
#pragma unroll
        for (int j = 0; j < 16; ++j) {
            const int ab = 255 - (int)(l[j] & 255u), a = ab >> 4, b = ab & 15;
            const int i1 = 127 - (int)(k1[a] & 127u), i2 = 127 - (int)(k2[b] & 127u);
            EIDX[(size_t)row * 128 + h * 16 + j] = i1 * 128 + i2;
            EGATE[(size_t)row * 128 + h * 16 + j] = ev[j] * inv;
        }
    }
    __syncthreads();
    STAMP(8);
    if (tid < TILE) ((float*)(ws + WS_RSTD))[tok0 + tid] = rs[tid];
}

__device__ __forceinline__ void peer_u_item(const Params& p, int tile, int j) {
    int tid = threadIdx.x;
    asm volatile("" : "+v"(tid));
    const int lane = tid & 63, wave = tid >> 6, q = lane & 7, g = lane >> 3;
    unsigned char* ws = p.ws;
    const size_t tok0 = (size_t)tile * TILE;
    unsigned char* arena = ws + WS_ARENA + (size_t)tile * ARENA_BYTES;
    const bf16_t* HB = (const bf16_t*)(ws + WS_HB) + tok0 * 1024;
    const int* EIDX = (const int*)(arena + AR_VNT);
    float* PD = (float*)(arena + AR_Q);
    const unsigned char* U8 = ws + WS_UTAB + (size_t)j * 128 + q * 16;
    int idx[16];
    {
        const int* er = EIDX + (size_t)(wave * 16) * 128 + g;
#pragma unroll
        for (int it = 0; it < 16; ++it) idx[it] = er[8 * it];
    }
    for (int tt = 0; tt < 16; ++tt) {
        const int row = wave * 16 + tt;
        const u32x4 xa = *(const u32x4*)(HB + (size_t)row * 1024 + j * 128 + q * 16), xb = *(const u32x4*)(HB + (size_t)row * 1024 + j * 128 + q * 16 + 8);
        u32x4 w[16];
#pragma unroll
        for (int it = 0; it < 16; ++it) w[it] = *(const u32x4*)(U8 + (size_t)idx[it] * 1024);
        asm volatile("" ::: "memory");
        if (tt + 1 < 16) {
            const int* er = EIDX + (size_t)(row + 1) * 128 + g;
#pragma unroll
            for (int it = 0; it < 16; ++it) idx[it] = er[8 * it];
        }
        asm volatile("" ::: "memory");
        f32x2 x2[8];
        x2[0] = (f32x2){bflo(xa.x), bfhi(xa.x)}; x2[1] = (f32x2){bflo(xa.y), bfhi(xa.y)}; x2[2] = (f32x2){bflo(xa.z), bfhi(xa.z)}; x2[3] = (f32x2){bflo(xa.w), bfhi(xa.w)};
        x2[4] = (f32x2){bflo(xb.x), bfhi(xb.x)}; x2[5] = (f32x2){bflo(xb.y), bfhi(xb.y)}; x2[6] = (f32x2){bflo(xb.z), bfhi(xb.z)}; x2[7] = (f32x2){bflo(xb.w), bfhi(xb.w)};
        float r0 = 0.f, r1 = 0.f;
#pragma unroll
        for (int it = 0; it < 16; ++it) {
            f32x2 acc = {0.f, 0.f};
            acc = __builtin_amdgcn_cvt_pk_f32_fp8(w[it].x, false) * x2[0] + acc; acc = __builtin_amdgcn_cvt_pk_f32_fp8(w[it].x, true) * x2[1] + acc;
            acc = __builtin_amdgcn_cvt_pk_f32_fp8(w[it].y, false) * x2[2] + acc; acc = __builtin_amdgcn_cvt_pk_f32_fp8(w[it].y, true) * x2[3] + acc;
            acc = __builtin_amdgcn_cvt_pk_f32_fp8(w[it].z, false) * x2[4] + acc; acc = __builtin_amdgcn_cvt_pk_f32_fp8(w[it].z, true) * x2[5] + acc;
            acc = __builtin_amdgcn_cvt_pk_f32_fp8(w[it].w, false) * x2[6] + acc; acc = __builtin_amdgcn_cvt_pk_f32_fp8(w[it].w, true) * x2[7] + acc;
            float sdot = acc.x + acc.y;
            sdot += __builtin_bit_cast(float, __builtin_amdgcn_update_dpp(0, __builtin_bit_cast(int, sdot), 0xB1, 0xF, 0xF, true));
            sdot += __builtin_bit_cast(float, __builtin_amdgcn_update_dpp(0, __builtin_bit_cast(int, sdot), 0x4E, 0xF, 0xF, true));
            sdot += __builtin_bit_cast(float, __builtin_amdgcn_update_dpp(0, __builtin_bit_cast(int, sdot), 0x141, 0xF, 0xF, true));
            if (q == (it & 7)) { if (it < 8) r0 = sdot; else r1 = sdot; }
        }
        float* pd = PD + ((size_t)row * 8 + j) * 128 + 8 * q + g;
        pd[0] = r0; pd[64] = r1;
    }
}

__device__ __forceinline__ void peer_v_item(const Params& p, LAS unsigned char* lds, int tile, int j) {
    int tid = threadIdx.x;
    asm volatile("" : "+v"(tid));
    const int lane = tid & 63, wave = tid >> 6, q = lane & 7, g = lane >> 3;
    unsigned char* ws = p.ws;
    const size_t tok0 = (size_t)tile * TILE;
    unsigned char* arena = ws + WS_ARENA + (size_t)tile * ARENA_BYTES;
    bf16_t* HB = (bf16_t*)(ws + WS_HB) + tok0 * 1024;
    float* OUT = p.out + tok0 * 1024;
    const int* EIDX = (const int*)(arena + AR_VNT);
    const float* EGATE = (const float*)(arena + AR_VNT + 65536);
    const float* PD = (const float*)(arena + AR_Q);
    const float* RSTD = (const float*)(ws + WS_RSTD) + tok0;
    float* SSQ = (float*)(ws + WS_SSQ) + tok0 * 8;
    const unsigned char* V8 = ws + WS_VTAB + (size_t)j * 128 + q * 16;
    LAS float* actl = (LAS float*)(lds + wave * 512);
    int idx[16];
    float pd0[8], pd1[8], g0, g1, rsd;
    {
        const int row = wave * 16;
        const int* er = EIDX + (size_t)row * 128 + g;
#pragma unroll
        for (int it = 0; it < 16; ++it) idx[it] = er[8 * it];
#pragma unroll
        for (int jj = 0; jj < 8; ++jj) { pd0[jj] = PD[((size_t)row * 8 + jj) * 128 + lane]; pd1[jj] = PD[((size_t)row * 8 + jj) * 128 + 64 + lane]; }
        g0 = EGATE[(size_t)row * 128 + lane]; g1 = EGATE[(size_t)row * 128 + 64 + lane]; rsd = RSTD[row];
    }
    for (int tt = 0; tt < 16; ++tt) {
        const int row = wave * 16 + tt;
        u32x4 w[16];
#pragma unroll
        for (int it = 0; it < 16; ++it) w[it] = *(const u32x4*)(V8 + (size_t)idx[it] * 1024);
        asm volatile("" ::: "memory");
        {
            const float sc = rsd * (1.0f / 64.0f);
            float s0 = 0.f, s1 = 0.f;
#pragma unroll
            for (int jj = 0; jj < 8; ++jj) { s0 += pd0[jj]; s1 += pd1[jj]; }
            actl[lane] = gelu_f(s0 * sc) * g0 * 0.25f;
            actl[64 + lane] = gelu_f(s1 * sc) * g1 * 0.25f;
        }
        if (tt + 1 < 16) {
            const int* er = EIDX + (size_t)(row + 1) * 128 + g;
#pragma unroll
            for (int it = 0; it < 16; ++it) idx[it] = er[8 * it];
#pragma unroll
            for (int jj = 0; jj < 8; ++jj) { pd0[jj] = PD[((size_t)(row + 1) * 8 + jj) * 128 + lane]; pd1[jj] = PD[((size_t)(row + 1) * 8 + jj) * 128 + 64 + lane]; }
            g0 = EGATE[(size_t)(row + 1) * 128 + lane]; g1 = EGATE[(size_t)(row + 1) * 128 + 64 + lane]; rsd = RSTD[row + 1];
        }
        asm volatile("" ::: "memory");
        LDS_WAIT();
        f32x2 y2[8];
#pragma unroll
        for (int i = 0; i < 8; ++i) y2[i] = (f32x2){0.f, 0.f};
#pragma unroll
        for (int it = 0; it < 16; ++it) {
            const float a = actl[8 * it + g];
            const f32x2 a2 = {a, a};
            y2[0] = __builtin_amdgcn_cvt_pk_f32_fp8(w[it].x, false) * a2 + y2[0]; y2[1] = __builtin_amdgcn_cvt_pk_f32_fp8(w[it].x, true) * a2 + y2[1];
            y2[2] = __builtin_amdgcn_cvt_pk_f32_fp8(w[it].y, false) * a2 + y2[2]; y2[3] = __builtin_amdgcn_cvt_pk_f32_fp8(w[it].y, true) * a2 + y2[3];
            y2[4] = __builtin_amdgcn_cvt_pk_f32_fp8(w[it].z, false) * a2 + y2[4]; y2[5] = __builtin_amdgcn_cvt_pk_f32_fp8(w[it].z, true) * a2 + y2[5];
            y2[6] = __builtin_amdgcn_cvt_pk_f32_fp8(w[it].w, false) * a2 + y2[6]; y2[7] = __builtin_amdgcn_cvt_pk_f32_fp8(w[it].w, true) * a2 + y2[7];
        }
        LDS_WAIT();
        const bool b5 = (lane & 32) != 0, b4 = (lane & 16) != 0, b3 = (lane & 8) != 0;
        f32x2 k4[4];
#pragma unroll
        for (int i = 0; i < 4; ++i) {
            const f32x2 keep = b5 ? y2[4 + i] : y2[i], send = b5 ? y2[i] : y2[4 + i];
            k4[i] = (f32x2){keep.x + __shfl_xor(send.x, 32), keep.y + __shfl_xor(send.y, 32)};
        }
        f32x2 k2[2];
#pragma unroll
        for (int i = 0; i < 2; ++i) {
            const f32x2 keep = b4 ? k4[2 + i] : k4[i], send = b4 ? k4[i] : k4[2 + i];
            k2[i] = (f32x2){keep.x + __shfl_xor(send.x, 16), keep.y + __shfl_xor(send.y, 16)};
        }
        f32x2 yv;
        {
            const f32x2 keep = b3 ? k2[1] : k2[0], send = b3 ? k2[0] : k2[1];
            yv = (f32x2){keep.x + __shfl_xor(send.x, 8), keep.y + __shfl_xor(send.y, 8)};
        }
        const int col = j * 128 + q * 16 + (b5 ? 8 : 0) + (b4 ? 4 : 0) + (b3 ? 2 : 0);
        float* hp = OUT + (size_t)row * 1024 + col;
        const float2 h1 = *(const float2*)hp;
        const float h20 = h1.x + yv.x, h21 = h1.y + yv.y;
        *(float2*)hp = make_float2(h20, h21);
        *(unsigned*)(HB + (size_t)row * 1024 + col) = pk2(h20, h21);
        const float ss = wave_sum(h20 * h20 + h21 * h21);
        if (lane == 0) SSQ[row * 8 + j] = ss;
    }
}

__device__ __forceinline__ void phase5(const Params& p, LAS unsigned char* lds, int tile) {
    int tid = threadIdx.x;
    asm volatile("" : "+v"(tid));
    const int lane = tid & 63, wave = tid >> 6;
    unsigned char* ws = p.ws;
    const size_t tok0 = (size_t)tile * TILE;
    unsigned char* arena = ws + WS_ARENA + (size_t)tile * ARENA_BYTES;
    bf16_t* HB = (bf16_t*)(ws + WS_HB) + tok0 * 1024;
    float* OUT = p.out + tok0 * 1024;
    LAS float* rs2 = (LAS float*)(lds + LDS_MISC + 512);
    if (tid < TILE) {
        const float* sq = (const float*)(ws + WS_SSQ) + (tok0 + tid) * 8;
        float ss = 0.f;
#pragma unroll
        for (int jj = 0; jj < 8; ++jj) ss += sq[jj];
        rs2[tid] = rsqrtf(ss * (1.0f / 1024.0f) + EPS);
    }
    bf16_t* PB = (bf16_t*)(arena + AR_HI);
    {
        const float* pp = p.in[1] + tok0 * 256;
        for (int r = wave; r < TILE; r += 8) {
            const float4 v = *(const float4*)(pp + (size_t)r * 256 + lane * 4);
            *(u32x2*)(PB + (size_t)r * 256 + lane * 4) = (u32x2){pk2(v.x, v.y), pk2(v.z, v.w)};
        }
    }
    __syncthreads();
    bf16_t* PP = (bf16_t*)(arena + AR_PP);
    {
        const bf16_t* WPROJ = (const bf16_t*)(ws + WS_WPROJ);
        for (int nc = 0; nc < 4; ++nc) {
            const int n0 = nc * 256;
            gemm_tile<256, true>(PB, 256, WPROJ + (size_t)n0 * 256, 256, 256, lds, [=](int row, int col, f32x4 v) {
                *(u32x2*)(PP + (size_t)row * 1024 + n0 + col) = (u32x2){pk2(v[0], v[1]), pk2(v[2], v[3])};
            });
        }
    }
    __syncthreads();
    {
        const bf16_t* WGATE = (const bf16_t*)(ws + WS_WGATE);
        for (int nc = 0; nc < 4; ++nc) {
            const int n0 = nc * 256;
            gemm_tile<256, true>(HB, 1024, WGATE + (size_t)n0 * 1024, 1024, 1024, lds, [=](int row, int col, f32x4 v) {
                const float r = rs2[row];
                const u32x2 pv = *(const u32x2*)(PP + (size_t)row * 1024 + n0 + col);
                float4 h = *(const float4*)(OUT + (size_t)row * 1024 + n0 + col);
                h.x += sigmoid_f(v[0] * r) * bflo(pv.x); h.y += sigmoid_f(v[1] * r) * bfhi(pv.x);
                h.z += sigmoid_f(v[2] * r) * bflo(pv.y); h.w += sigmoid_f(v[3] * r) * bfhi(pv.y);
                *(float4*)(OUT + (size_t)row * 1024 + n0 + col) = h;
            });
        }
    }
    __syncthreads();
    STAMP(10);
    final_rows(p, tok0);
    __syncthreads();
    STAMP(11);
}

#define XB_TMO      128
#define XB_XCNT(j)  (256  + 64 * (j))
#define XB_XSUB(j)  (1280 + 64 * (j))
#define XB_XGEN(j)  (2304 + 64 * (j))
#define XB_TOP      3328
#define XB_TOPGEN   3392
#define XCD_BAR_WORDS 3456
#define XB_SPIN_CAP (1u << 22)
__device__ __forceinline__ unsigned xb_ld(unsigned* p)              { return __hip_atomic_load(p, __ATOMIC_RELAXED, __HIP_MEMORY_SCOPE_AGENT); }
__device__ __forceinline__ unsigned xb_add(unsigned* p, unsigned v) { return __hip_atomic_fetch_add(p, v, __ATOMIC_RELAXED, __HIP_MEMORY_SCOPE_AGENT); }
__device__ __forceinline__ unsigned xb_xcc_id() { return (unsigned)__builtin_amdgcn_s_getreg((3 << 11) | 20) & 0xFu; }
#define XB_SPIN(cond, bar) do { unsigned _sp = 0; while (cond) { __builtin_amdgcn_s_sleep(1); \
    if ((++_sp & 255u) == 0u) { if (xb_ld(&(bar)[XB_TMO])) break; if (_sp > XB_SPIN_CAP) { atomicAdd(&(bar)[XB_TMO], 1u); break; } } } } while (0)
struct XcdBarrier { unsigned* bar; unsigned x; volatile LAS unsigned* st; };
__device__ __forceinline__ XcdBarrier xcd_barrier_post(unsigned* bar, volatile LAS unsigned* st) {
    XcdBarrier b; b.bar = bar; b.x = xb_xcc_id(); b.st = st;
    if (threadIdx.x == 0) (void)xb_add(&bar[XB_XCNT(b.x)], 1u);
    return b;
}
__device__ __forceinline__ void xcd_barrier_complete(unsigned* bar, unsigned x, unsigned& nloc, unsigned& nx) {
    const unsigned G = gridDim.x * gridDim.y * gridDim.z;
    unsigned sum, cnt, mine, sp = 0u;
    for (;;) {
        sum = 0u; cnt = 0u; mine = 0u;
#pragma unroll
        for (unsigned j = 0; j < 16; ++j) { const unsigned c = xb_ld(&bar[XB_XCNT(j)]); sum += c; cnt += (c > 0u) ? 1u : 0u; mine = (j == x) ? c : mine; }
        if (sum == G) break;
        __builtin_amdgcn_s_sleep(1);
        if ((++sp & 255u) == 0u) { if (xb_ld(&bar[XB_TMO])) break; if (sp > XB_SPIN_CAP) { atomicAdd(&bar[XB_TMO], 1u); break; } }
    }
    nloc = mine > 0u ? mine : 1u; nx = cnt > 0u ? cnt : 1u;
}
__device__ __forceinline__ void xcd_barrier(const XcdBarrier& b) {
    asm volatile("s_waitcnt vmcnt(0)" ::: "memory");
    __syncthreads();
    if (threadIdx.x == 0) {
        unsigned* bar = b.bar;
        __builtin_amdgcn_s_waitcnt(0);
        unsigned nloc = b.st[0], nx = b.st[1];
        if (nloc == 0u) { xcd_barrier_complete(bar, b.x, nloc, nx); b.st[0] = nloc; b.st[1] = nx; }
        const unsigned old = xb_add(&bar[XB_XSUB(b.x)], 1u);
        const unsigned gen = old / nloc;
        if (old + 1u == (gen + 1u) * nloc) {
            __builtin_amdgcn_fence(__ATOMIC_RELEASE, "agent");
            asm volatile("s_waitcnt vmcnt(0)" ::: "memory");
            const unsigned og = xb_add(&bar[XB_TOP], 1u);
            const unsigned tg = og / nx;
            if (og + 1u == (tg + 1u) * nx) xb_add(&bar[XB_TOPGEN], 1u);
            else XB_SPIN(xb_ld(&bar[XB_TOPGEN]) == tg, bar);
            __builtin_amdgcn_fence(__ATOMIC_ACQUIRE, "agent");
            xb_add(&bar[XB_XGEN(b.x)], 1u);
            asm volatile("s_waitcnt vmcnt(0)" ::: "memory");
        } else {
            XB_SPIN(xb_ld(&bar[XB_XGEN(b.x)]) == gen, bar);
            __builtin_amdgcn_fence(__ATOMIC_ACQUIRE, "agent");
            asm volatile("s_waitcnt vmcnt(0)" ::: "memory");
        }
    }
    __syncthreads();
}

__global__ void __launch_bounds__(NTHREADS) fwd_kernel(Params p) {
    __shared__ __attribute__((aligned(16))) unsigned char lds_raw[LDS_BYTES];
    LAS unsigned char* lds = (LAS unsigned char*)lds_raw;
    cg::grid_group grid = cg::this_grid();
    volatile LAS unsigned* bst = (volatile LAS unsigned*)(lds + LDS_MISC + 1024);
    if (threadIdx.x == 0) { bst[0] = 0u; bst[1] = 0u; }
    __syncthreads();
    XcdBarrier bar = xcd_barrier_post((unsigned*)(p.ws + WS_BAR), bst);
    STAMP(0);
#ifdef PROBE_A
    if (blockIdx.x == 0 && threadIdx.x == 0) *(unsigned*)(p.ws + WS_END) = 0u;
#endif
    phase0(p, lds);
    STAMP(1);
    grid.sync();
    STAMP(2);
    for (int tile = blockIdx.x; tile < NTILES; tile += gridDim.x) phase1(p, lds, tile);
    STAMP(3);
    xcd_barrier(bar);
    STAMP(4);
    for (int tile = blockIdx.x; tile < NTILES; tile += gridDim.x) phase2(p, lds, tile);
    STAMP(12);
    xcd_barrier(bar);
    STAMP(13);
    for (int it = blockIdx.x; it < NTILES * 8; it += gridDim.x) peer_u_item(p, it >> 3, it & 7);
    STAMP(14);
    xcd_barrier(bar);
    STAMP(15);
    for (int it = blockIdx.x; it < NTILES * 8; it += gridDim.x) peer_v_item(p, lds, it >> 3, it & 7);
    STAMP(16);
    xcd_barrier(bar);
    STAMP(17);
    for (int tile = blockIdx.x; tile < NTILES; tile += gridDim.x) phase5(p, lds, tile);
#ifdef PROBE_A
    {
        LAS unsigned long long* ts = (LAS unsigned long long*)(lds + LDS_MISC + 2048);
        unsigned* mx = (unsigned*)(p.ws + WS_END);
        if (threadIdx.x == 0) atomicMax(mx, (unsigned)(ts[PROBE_B] - ts[PROBE_A]));
        grid.sync();
        if (blockIdx.x == 0 && threadIdx.x == 0) {
            const unsigned long long dly = (unsigned long long)__hip_atomic_load(mx, __ATOMIC_RELAXED, __HIP_MEMORY_SCOPE_AGENT) * PROBE_MUL, t_end = __builtin_amdgcn_s_memrealtime();
            while (__builtin_amdgcn_s_memrealtime() - t_end < dly) __builtin_amdgcn_s_sleep(8);
        }
    }
#endif
}

extern "C" void kernel_launch(void* const* d_in, const int* in_sizes, int n_in, void* d_out, int out_size, void* d_ws, size_t ws_size,
                              hipStream_t stream) {
    static int grid_blocks = 0;
    if (!grid_blocks) {
        int dev = 0, cus = 0, per_cu = 0;
        (void)hipGetDevice(&dev);
        (void)hipDeviceGetAttribute(&cus, hipDeviceAttributeMultiprocessorCount, dev);
        (void)hipOccupancyMaxActiveBlocksPerMultiprocessor(&per_cu, fwd_kernel, NTHREADS, 0);
        if (per_cu < 1) { fprintf(stderr, "kernel_launch: occupancy query says %d blocks per CU\n", per_cu); per_cu = 1; }
        grid_blocks = cus * 1;
        if (grid_blocks > NTILES) grid_blocks = NTILES;
        if (ws_size < WS_END) fprintf(stderr, "kernel_launch: workspace too small: %zu < %zu\n", ws_size, (size_t)WS_END);
        fprintf(stderr, "kernel_launch: cus=%d per_cu=%d grid=%d ws=%zu need=%zu\n", cus, per_cu, grid_blocks, ws_size, (size_t)WS_END);
    }
    (void)hipMemsetAsync((unsigned char*)d_ws + WS_BAR, 0, 16384, stream);
    Params p{};
    for (int i = 0; i < 30; ++i) p.in[i] = (const float*)d_in[i];
    p.out = (float*)d_out;
    p.ws = (unsigned char*)d_ws;
    void* args[] = {&p};
    hipError_t e = hipLaunchCooperativeKernel((void*)fwd_kernel, dim3(grid_blocks), dim3(NTHREADS), args, 0, stream);
    if (e != hipSuccess) fprintf(stderr, "cooperative launch failed: %s (grid %d)\n", hipGetErrorString(e), grid_blocks);
}
```

```cpp
#include <hip/hip_runtime.h>
#include <hip/hip_cooperative_groups.h>
#include <cstdio>
#include <cstdint>
namespace cg = cooperative_groups;


#define LAS __attribute__((address_space(3)))
typedef unsigned short bf16_t;
typedef short bf16x8 __attribute__((ext_vector_type(8)));
typedef float f32x4 __attribute__((ext_vector_type(4)));
typedef float f32x2 __attribute__((ext_vector_type(2)));
typedef unsigned u32x4 __attribute__((ext_vector_type(4)));
typedef unsigned u32x2 __attribute__((ext_vector_type(2)));

constexpr int T_TOK = 16 * 2048, SEQ = 2048, D = 1024, DIN = 1536;
constexpr int NG = 32;
constexpr int TILE = 128, NTILES = T_TOK / TILE, TPS = SEQ / TILE;
constexpr float EPS = 1e-6f;
constexpr int NTHREADS = 512;

constexpr size_t WS_WIN = 0;
constexpr size_t WS_WGLU = WS_WIN + (size_t)1536 * 1024 * 2;
constexpr size_t WS_WOUT = WS_WGLU + (size_t)512 * 512 * 2;
constexpr size_t WS_WQ = WS_WOUT + (size_t)1024 * 1024 * 2;
constexpr size_t WS_KEYS = WS_WQ + (size_t)2048 * 1024 * 2;
constexpr size_t WS_WGATE = WS_KEYS + (size_t)16 * 128 * 128 * 2;
constexpr size_t WS_WPROJ = WS_WGATE + (size_t)1024 * 1024 * 2;
constexpr size_t WS_WSM = WS_WPROJ + (size_t)1024 * 256 * 2;
constexpr size_t WS_TT = WS_WSM + (size_t)4 * 128 * 128 * 2;
constexpr size_t WS_WST = WS_TT + (size_t)32 * 128 * 256 * 2;
constexpr size_t WS_PW = WS_WST + (size_t)32 * 128 * 128 * 2;
constexpr size_t WS_STILE = WS_PW + (size_t)32 * 17 * 128 * 4;
constexpr size_t WS_UTAB = WS_STILE + (size_t)256 * 32 * 128 * 4;
constexpr size_t WS_VTAB = WS_UTAB + (size_t)16384 * 1024;
constexpr size_t WS_RSTD = WS_VTAB + (size_t)16384 * 1024;
constexpr size_t WS_SSQ = WS_RSTD + (size_t)T_TOK * 4;
constexpr size_t WS_BAR = WS_SSQ + (size_t)T_TOK * 8 * 4;
constexpr size_t WS_MIXA = WS_BAR + 16384;
constexpr size_t WS_HB = WS_MIXA + (size_t)T_TOK * 1024 * 2;
constexpr size_t WS_ARENA = WS_HB + (size_t)T_TOK * 1024 * 2;
constexpr size_t AR_XS = 0;
constexpr size_t AR_HLOC = 131072;
constexpr size_t AR_UG = 393216;
constexpr size_t AR_Q = 0;
constexpr size_t AR_PP = 0;
constexpr size_t AR_GV = 524288;
constexpr size_t AR_VNT = 655360;
constexpr size_t AR_HI = 786432;
constexpr size_t ARENA_BYTES = 917504;
constexpr size_t WS_END = WS_ARENA + (size_t)NTILES * ARENA_BYTES;

constexpr int LDS_MISC = 147456;
constexpr int LDS_BYTES = LDS_MISC + 4096;

struct Params {
    const float* in[30];
    float* out;
    unsigned char* ws;
};

__device__ __forceinline__ unsigned f2bf(float f) {
    unsigned u = __float_as_uint(f);
    return (u + 0x7fffu + ((u >> 16) & 1u)) >> 16;
}
__device__ __forceinline__ unsigned pk2(float lo, float hi) { return f2bf(lo) | (f2bf(hi) << 16); }
__device__ __forceinline__ float bflo(unsigned w) { return __uint_as_float(w << 16); }
__device__ __forceinline__ float bfhi(unsigned w) { return __uint_as_float(w & 0xffff0000u); }
__device__ __forceinline__ float bf2f(bf16_t b) { return __uint_as_float((unsigned)b << 16); }
__device__ __forceinline__ float wave_sum(float v) {
#pragma unroll
    for (int o = 1; o < 64; o <<= 1) v += __shfl_xor(v, o);
    return v;
}
__device__ __forceinline__ float gelu_f(float v) {
    const float av = fabsf(v);
    const float t = __builtin_amdgcn_rcpf(av * 0.2316418882f + 1.0f);
    float q = t * 0.5307027145f + (-0.7265760135f);
    q = q * t + 0.7107068705f; q = q * t + (-0.142248368f); q = q * t + 0.127414796f; q = q * t;
    const float e = __builtin_amdgcn_exp2f(v * v * (-0.72134752044f));
    const float m = v * (q * e);
    return v < 0.f ? m : v - m;
}
__device__ __forceinline__ float sigmoid_f(float x) {
    return __builtin_amdgcn_rcpf(1.0f + __builtin_amdgcn_exp2f(x * (-1.44269504089f)));
}
#define LDS_WAIT() asm volatile("s_waitcnt lgkmcnt(0)" ::: "memory")
#ifdef PROBE_A
#define STAMP(i) do { if (threadIdx.x == 0) ((LAS unsigned long long*)(lds + LDS_MISC + 2048))[i] = __builtin_amdgcn_s_memrealtime(); } while (0)
#else
#define STAMP(i) do { } while (0)
#endif

template <int BN, bool TR, class Epi>
__device__ __forceinline__ void gemm_tile(const bf16_t* __restrict__ A, int lda, const bf16_t* __restrict__ Bt, int ldb, int K,
                                          LAS unsigned char* lds, const Epi& epi) {
    constexpr int NT = BN / 64;
    constexpr int NPB = BN / 64;
    constexpr int NP = 2 + NPB;
    constexpr int A_BYTES = 128 * 128;
    constexpr int B_BYTES = BN * 128;
    constexpr int STAGE = A_BYTES + B_BYTES;
    int tid = threadIdx.x;
    asm volatile("" : "+v"(tid));
    const int lane = tid & 63, wave = __builtin_amdgcn_readfirstlane(tid >> 6), wm = wave >> 2, wn = wave & 3;
    f32x4 acc[4][NT];
#pragma unroll
    for (int i = 0; i < 4; ++i)
#pragma unroll
        for (int j = 0; j < NT; ++j) acc[i][j] = (f32x4){0.f, 0.f, 0.f, 0.f};
    const int prow = lane >> 3;
    const bf16_t* asrc[2]; const bf16_t* bsrc[NPB];
#pragma unroll
    for (int i = 0; i < 2; ++i) { const int row = 8 * (wave + 8 * i) + prow; asrc[i] = A + (size_t)row * lda + (((lane & 7) ^ ((row >> 1) & 7)) << 3); }
#pragma unroll
    for (int i = 0; i < NPB; ++i) { const int row = 8 * (wave + 8 * i) + prow; bsrc[i] = Bt + (size_t)row * ldb + (((lane & 7) ^ ((row >> 1) & 7)) << 3); }
    const int KT = K / 64;
    const int fr = lane & 15, fq = lane >> 4;
    const int fsw = (lane >> 1) & 7;
#define G_DMA(kt_, st_) do { const int k0_ = (kt_) * 64; LAS unsigned char* sb_ = lds + (st_) * STAGE; \
        _Pragma("unroll") for (int i = 0; i < 2; ++i) __builtin_amdgcn_global_load_lds((const __attribute__((address_space(1))) unsigned*)(asrc[i] + k0_), (LAS unsigned*)(sb_ + (wave + 8 * i) * 1024), 16, 0, 0); \
        _Pragma("unroll") for (int i = 0; i < NPB; ++i) __builtin_amdgcn_global_load_lds((const __attribute__((address_space(1))) unsigned*)(bsrc[i] + k0_), (LAS unsigned*)(sb_ + A_BYTES + (wave + 8 * i) * 1024), 16, 0, 0); } while (0)
    G_DMA(0, 0);
    if (KT > 1) G_DMA(1, 1);
    int st = 0;
    for (int kt = 0; kt < KT; ++kt) {
        if (kt + 1 < KT) asm volatile("s_waitcnt vmcnt(%0)" :: "n"(NP) : "memory");
        else asm volatile("s_waitcnt vmcnt(0)" ::: "memory");
        asm volatile("s_waitcnt lgkmcnt(0)" ::: "memory");
        __builtin_amdgcn_s_barrier();
        if (kt + 2 < KT) { const int st2 = (st >= 1) ? st - 1 : 2; G_DMA(kt + 2, st2); }
        LAS unsigned char* la = lds + st * STAGE + (wm * 64 + fr) * 128;
        LAS unsigned char* lb = lds + st * STAGE + A_BYTES + (wn * (BN / 4) + fr) * 128;
#pragma unroll
        for (int kk = 0; kk < 2; ++kk) {
            const int choff = ((kk * 4 + fq) ^ fsw) << 4;
            bf16x8 af[4], bfr[NT];
#pragma unroll
            for (int i = 0; i < 4; ++i) af[i] = *(LAS bf16x8*)(la + i * 16 * 128 + choff);
#pragma unroll
            for (int j = 0; j < NT; ++j) bfr[j] = *(LAS bf16x8*)(lb + j * 16 * 128 + choff);
#pragma unroll
            for (int i = 0; i < 4; ++i)
#pragma unroll
                for (int j = 0; j < NT; ++j) {
                    if (TR) acc[i][j] = __builtin_amdgcn_mfma_f32_16x16x32_bf16(bfr[j], af[i], acc[i][j], 0, 0, 0);
                    else    acc[i][j] = __builtin_amdgcn_mfma_f32_16x16x32_bf16(af[i], bfr[j], acc[i][j], 0, 0, 0);
                }
        }
        st = (st == 2) ? 0 : st + 1;
    }
#undef G_DMA
    asm volatile("s_waitcnt lgkmcnt(0)" ::: "memory");
    __builtin_amdgcn_s_barrier();
#pragma unroll
    for (int i = 0; i < 4; ++i)
#pragma unroll
        for (int j = 0; j < NT; ++j) {
            if (TR) epi(wm * 64 + i * 16 + fr, wn * (BN / 4) + j * 16 + 4 * fq, acc[i][j]);
            else    epi(wm * 64 + i * 16 + 4 * fq, wn * (BN / 4) + j * 16 + fr, acc[i][j]);
        }
}

__device__ __forceinline__ void rows_cvt_rstd(const float* __restrict__ src, bf16_t* __restrict__ dst, LAS float* rs) {
    const int lane = threadIdx.x & 63, wave = threadIdx.x >> 6;
    for (int rb = 0; rb < 16; rb += 4) {
        float4 a[4][4];
#pragma unroll
        for (int i = 0; i < 4; ++i) {
            const float4* xr = (const float4*)(src + (size_t)(wave * 16 + rb + i) * 1024);
#pragma unroll
            for (int j = 0; j < 2; ++j) { a[i][2 * j] = xr[lane * 2 + 128 * j]; a[i][2 * j + 1] = xr[lane * 2 + 1 + 128 * j]; }
        }
        asm volatile("" ::: "memory");
#pragma unroll
        for (int i = 0; i < 4; ++i) {
            const int r = wave * 16 + rb + i;
            float ss = 0.f;
#pragma unroll
            for (int j = 0; j < 2; ++j) {
                const float4 u = a[i][2 * j], v = a[i][2 * j + 1];
                ss += u.x * u.x + u.y * u.y + u.z * u.z + u.w * u.w + v.x * v.x + v.y * v.y + v.z * v.z + v.w * v.w;
                *(u32x4*)(dst + (size_t)r * 1024 + lane * 8 + 512 * j) = (u32x4){pk2(u.x, u.y), pk2(u.z, u.w), pk2(v.x, v.y), pk2(v.z, v.w)};
            }
            ss = wave_sum(ss);
            if (lane == 0) rs[r] = rsqrtf(ss * (1.0f / 1024.0f) + EPS);
        }
    }
}
__device__ __forceinline__ void rows_rms512_inplace(bf16_t* base) {
    const int lane = threadIdx.x & 63, wave = threadIdx.x >> 6;
    for (int rb = 0; rb < 16; rb += 8) {
        u32x4 w[8];
#pragma unroll
        for (int i = 0; i < 8; ++i) w[i] = *(const u32x4*)(base + (size_t)(wave * 16 + rb + i) * 1024 + lane * 8);
        asm volatile("" ::: "memory");
#pragma unroll
        for (int i = 0; i < 8; ++i) {
            const float f0 = bflo(w[i].x), f1 = bfhi(w[i].x), f2 = bflo(w[i].y), f3 = bfhi(w[i].y), f4 = bflo(w[i].z), f5 = bfhi(w[i].z), f6 = bflo(w[i].w), f7 = bfhi(w[i].w);
            float ss = f0 * f0 + f1 * f1 + f2 * f2 + f3 * f3 + f4 * f4 + f5 * f5 + f6 * f6 + f7 * f7;
            ss = wave_sum(ss);
            const float rr = rsqrtf(ss * (1.0f / 512.0f) + EPS);
            *(u32x4*)(base + (size_t)(wave * 16 + rb + i) * 1024 + lane * 8) = (u32x4){pk2(f0 * rr, f1 * rr), pk2(f2 * rr, f3 * rr), pk2(f4 * rr, f5 * rr), pk2(f6 * rr, f7 * rr)};
        }
    }
}

__device__ __forceinline__ void transpose_item(const float* __restrict__ W, int K, int N, bf16_t* __restrict__ WT,
                                               const float* __restrict__ g1, const float* __restrict__ g2, int split,
                                               LAS float* scr, int item, int lane) {
    const int nblk = N / 32, kb = item / nblk, nb = item % nblk, k0 = 64 * kb, n0 = 32 * nb;
#pragma unroll 8
    for (int i = 0; i < 32; ++i) {
        const int kk = 2 * i + (lane >> 5), k = k0 + kk;
        float w = W[(size_t)k * N + n0 + (lane & 31)];
        if (g1) w *= (k < split) ? g1[k] : g2[k - split];
        scr[kk * 33 + (lane & 31)] = w;
    }
    LDS_WAIT();
    const int c = lane & 7;
#pragma unroll
    for (int j = 0; j < 4; ++j) {
        const int n = (lane >> 3) + 8 * j;
        const LAS float* s = scr + (8 * c) * 33 + n;
        u32x4 o;
        o.x = pk2(s[0 * 33], s[1 * 33]); o.y = pk2(s[2 * 33], s[3 * 33]);
        o.z = pk2(s[4 * 33], s[5 * 33]); o.w = pk2(s[6 * 33], s[7 * 33]);
        *(u32x4*)(WT + (size_t)(n0 + n) * K + k0 + 8 * c) = o;
    }
    LDS_WAIT();
}

__device__ __forceinline__ void s5_tables(const Params& p, LAS unsigned char* lds, int g) {
    const int tid = threadIdx.x;
    LAS float* apr = (LAS float*)lds;
    LAS float* api = apr + 9 * 64;
    LAS float* bbr = api + 9 * 64;
    LAS float* bbi = bbr + 1024;
    LAS float* ccr = bbi + 1024;
    LAS float* cci = ccr + 1024;
    LAS float* kk = cci + 1024;
    const float* a_re = p.in[4]; const float* a_im = p.in[5]; const float* log_dt = p.in[6];
    const float* b_re = p.in[7]; const float* b_im = p.in[8]; const float* c_re = p.in[9]; const float* c_im = p.in[10];
    const float* dsk = p.in[11];
    float* PW = (float*)(p.ws + WS_PW) + (size_t)g * 17 * 128;
    bf16_t* TT = (bf16_t*)(p.ws + WS_TT) + (size_t)g * 128 * 256;
    bf16_t* WST = (bf16_t*)(p.ws + WS_WST) + (size_t)g * 128 * 128;
    if (tid < 64) {
        const int n = tid;
        const float lr = a_re[g * 64 + n], li = a_im[g * 64 + n], dt = expf(log_dt[g]);
        const float mag = expf(lr * dt), ang = li * dt;
        float rev = ang * 0.15915494309189535f;
        rev = rev - floorf(rev);
        const float ar = mag * __builtin_amdgcn_cosf(rev), ai = mag * __builtin_amdgcn_sinf(rev);
        float pr = 1.f, pi = 0.f;
        apr[n] = pr; api[n] = pi;
        for (int k = 1; k <= 8; ++k) {
            const float nr = pr * ar - pi * ai, ni = pr * ai + pi * ar;
            pr = nr; pi = ni; apr[k * 64 + n] = pr; api[k * 64 + n] = pi;
        }
        const float a8r = pr, a8i = pi;
        float qr = 1.f, qi = 0.f;
        for (int c = 0; c <= 16; ++c) {
            PW[c * 128 + n] = qr; PW[c * 128 + 64 + n] = qi;
            const float nr = qr * a8r - qi * a8i, ni = qr * a8i + qi * a8r;
            qr = nr; qi = ni;
        }
        const float nr = ar - 1.0f, ni = ai, den = lr * lr + li * li;
        const float cr = (nr * lr + ni * li) / den, ci = (ni * lr - nr * li) / den;
        for (int c2 = 0; c2 < 16; ++c2) {
            const float br = b_re[(size_t)(g * 64 + n) * 16 + c2], bi = b_im[(size_t)(g * 64 + n) * 16 + c2];
            bbr[n * 16 + c2] = cr * br - ci * bi;
            bbi[n * 16 + c2] = cr * bi + ci * br;
        }
    }
    for (int i = tid; i < 1024; i += NTHREADS) { ccr[i] = c_re[(size_t)g * 1024 + i]; cci[i] = c_im[(size_t)g * 1024 + i]; }
    __syncthreads();
    for (int e = tid; e < 2048; e += NTHREADS) {
        const int k = e >> 8, c = (e >> 4) & 15, c2 = e & 15;
        float s = 0.f;
        for (int n = 0; n < 64; ++n) {
            const float pr = apr[k * 64 + n], pi = api[k * 64 + n], br = bbr[n * 16 + c2], bi = bbi[n * 16 + c2];
            const float tr = pr * br - pi * bi, ti = pr * bi + pi * br;
            s += ccr[c * 64 + n] * tr - cci[c * 64 + n] * ti;
        }
        if (k == 0 && c == c2) s += dsk[g * 16 + c];
        kk[e] = s;
    }
    __syncthreads();
    for (int e = tid; e < 128 * 256; e += NTHREADS) {
        const int row = e >> 8, col = e & 255, tau = row >> 4, c = row & 15;
        float v;
        if (col < 128) {
            const int sg = col >> 4, c2 = col & 15;
            v = (tau >= sg) ? kk[((tau - sg) << 8) + (c << 4) + c2] : 0.f;
        } else {
            const int n = col & 63;
            const float pr = apr[(tau + 1) * 64 + n], pi = api[(tau + 1) * 64 + n];
            const float cr = ccr[c * 64 + n], ci = cci[c * 64 + n];
            v = (col < 192) ? (cr * pr - ci * pi) : -(cr * pi + ci * pr);
        }
        TT[e] = (bf16_t)f2bf(v);
    }
    for (int e = tid; e < 128 * 128; e += NTHREADS) {
        const int row = e >> 7, col = e & 127, part = row >> 6, n = row & 63, sg = col >> 4, c2 = col & 15;
        const float pr = apr[(7 - sg) * 64 + n], pi = api[(7 - sg) * 64 + n], br = bbr[n * 16 + c2], bi = bbi[n * 16 + c2];
        const float v = part ? (pr * bi + pi * br) : (pr * br - pi * bi);
        WST[e] = (bf16_t)f2bf(v);
    }
    __syncthreads();
}

__device__ __forceinline__ void phase0(const Params& p, LAS unsigned char* lds) {
    const int tid = threadIdx.x, lane = tid & 63, wave = tid >> 6;
    unsigned char* ws = p.ws;
    for (int g = blockIdx.x; g < NG; g += gridDim.x) s5_tables(p, lds, g);
    {
        LAS float* scr = (LAS float*)(lds + wave * 8448);
        const int gw = blockIdx.x * 8 + wave, ngw = gridDim.x * 8;
        constexpr int I0 = 16 * 48, I1 = 8 * 16, I2 = 16 * 32, I3 = 16 * 64, I4 = 16 * 32, I5 = 4 * 32;
        for (int it = gw; it < I0 + I1 + I2 + I3 + I4 + I5; it += ngw) {
            int r = it;
            if (r < I0) { transpose_item(p.in[3], 1024, 1536, (bf16_t*)(ws + WS_WIN), p.in[2], p.in[2], 1024, scr, r, lane); continue; } r -= I0;
            if (r < I1) { transpose_item(p.in[12], 512, 512, (bf16_t*)(ws + WS_WGLU), nullptr, nullptr, 0, scr, r, lane); continue; } r -= I1;
            if (r < I2) { transpose_item(p.in[20], 1024, 1024, (bf16_t*)(ws + WS_WOUT), p.in[18], p.in[19], 512, scr, r, lane); continue; } r -= I2;
            if (r < I3) { transpose_item(p.in[22], 1024, 2048, (bf16_t*)(ws + WS_WQ), p.in[21], p.in[21], 1024, scr, r, lane); continue; } r -= I3;
            if (r < I4) { transpose_item(p.in[27], 1024, 1024, (bf16_t*)(ws + WS_WGATE), p.in[26], p.in[26], 1024, scr, r, lane); continue; } r -= I4;
            transpose_item(p.in[28], 256, 1024, (bf16_t*)(ws + WS_WPROJ), nullptr, nullptr, 0, scr, r, lane);
        }
    }
    const size_t gt = (size_t)blockIdx.x * NTHREADS + tid, ngt = (size_t)gridDim.x * NTHREADS;
    {
        const float4* src = (const float4*)p.in[23]; u32x2* dst = (u32x2*)(ws + WS_KEYS);
        for (size_t i = gt; i < 65536; i += ngt) { const float4 v = src[i]; dst[i] = (u32x2){pk2(v.x, v.y), pk2(v.z, v.w)}; }
    }
    {
        const float4* src = (const float4*)p.in[16]; u32x2* dst = (u32x2*)(ws + WS_WSM);
        for (size_t i = gt; i < 16384; i += ngt) {
            float4 v = src[i];
            const int t = (int)((i >> 5) & 127), s0 = (int)(i & 31) * 4;
            if (s0 + 0 > t) v.x = 0.f; if (s0 + 1 > t) v.y = 0.f; if (s0 + 2 > t) v.z = 0.f; if (s0 + 3 > t) v.w = 0.f;
            dst[i] = (u32x2){pk2(v.x, v.y), pk2(v.z, v.w)};
        }
    }
    {
        const float4* su = (const float4*)p.in[24]; const float4* sv = (const float4*)p.in[25];
        const float4* g4 = (const float4*)p.in[21];
        unsigned* du = (unsigned*)(ws + WS_UTAB); unsigned* dv = (unsigned*)(ws + WS_VTAB);
        for (size_t i = gt; i < (size_t)16384 * 256; i += ngt) {
            float4 v = su[i]; const float4 g = g4[i & 255];
            int w = __builtin_amdgcn_cvt_pk_fp8_f32(v.x * g.x * 64.f, v.y * g.y * 64.f, 0, false);
            w = __builtin_amdgcn_cvt_pk_fp8_f32(v.z * g.z * 64.f, v.w * g.w * 64.f, w, true);
            du[i] = (unsigned)w;
            v = sv[i];
            w = __builtin_amdgcn_cvt_pk_fp8_f32(v.x * 4.f, v.y * 4.f, 0, false);
            w = __builtin_amdgcn_cvt_pk_fp8_f32(v.z * 4.f, v.w * 4.f, w, true);
            dv[i] = (unsigned)w;
        }
    }
}

__device__ __forceinline__ void phase1(const Params& p, LAS unsigned char* lds, int tile) {
    int tid = threadIdx.x;
    asm volatile("" : "+v"(tid));
    const int lane = tid & 63, wave = tid >> 6;
    unsigned char* ws = p.ws;
    const size_t tok0 = (size_t)tile * TILE;
    unsigned char* arena = ws + WS_ARENA + (size_t)tile * ARENA_BYTES;
    bf16_t* XB = (bf16_t*)(ws + WS_HB) + tok0 * 1024;
    bf16_t* XS = (bf16_t*)(arena + AR_XS);
    bf16_t* UG = (bf16_t*)(arena + AR_UG);
    bf16_t* GVT = (bf16_t*)(arena + AR_GV);
    float* HLOC = (float*)(arena + AR_HLOC);
    bf16_t* MIXA = (bf16_t*)(ws + WS_MIXA) + tok0 * 1024;
    LAS float* rs = (LAS float*)(lds + LDS_MISC);
    const float* x = p.in[0];

    rows_cvt_rstd(x + tok0 * 1024, XB, rs);
    __syncthreads();
    STAMP(20);

    const bf16_t* WIN = (const bf16_t*)(ws + WS_WIN);
    for (int nc = 0; nc < 2; ++nc) {
        const int n0 = nc * 256;
        gemm_tile<256, true>(XB, 1024, WIN + (size_t)n0 * 1024, 1024, 1024, lds, [=](int row, int col, f32x4 v) {
            const float r = rs[row];
            const int gc = n0 + col, g = gc >> 4, c0 = gc & 15;
            *(u32x2*)(XS + ((size_t)g * 128 + row) * 16 + c0) = (u32x2){pk2(v[0] * r, v[1] * r), pk2(v[2] * r, v[3] * r)};
        });
    }
    for (int nc = 2; nc < 4; ++nc) {
        const int n0 = nc * 256;
        gemm_tile<256, true>(XB, 1024, WIN + (size_t)n0 * 1024, 1024, 1024, lds, [=](int row, int col, f32x4 v) {
            const float r = rs[row];
            const int gc = n0 + col - 512;
            *(u32x2*)(UG + (size_t)row * 512 + gc) = (u32x2){pk2(gelu_f(v[0] * r), gelu_f(v[1] * r)), pk2(gelu_f(v[2] * r), gelu_f(v[3] * r))};
        });
    }
    for (int nc = 4; nc < 6; ++nc) {
        const int n0 = nc * 256;
        gemm_tile<256, false>(XB, 1024, WIN + (size_t)n0 * 1024, 1024, 1024, lds, [=](int row, int col, f32x4 v) {
            const int gc = n0 + col - 1024;
            *(u32x2*)(GVT + (size_t)gc * 128 + row) = (u32x2){pk2(gelu_f(v[0] * rs[row]), gelu_f(v[1] * rs[row + 1])),
                                                              pk2(gelu_f(v[2] * rs[row + 2]), gelu_f(v[3] * rs[row + 3]))};
        });
    }
    __syncthreads();
    STAMP(21);

    LAS float* stat = (LAS float*)lds;
    {
        const int s = tid & 127, head = tid >> 7;
        float sum = 0.f, sq = 0.f;
        for (int d = 0; d < 128; ++d) { const float v = bf2f(GVT[(size_t)(head * 128 + d) * 128 + s]); sum += v; sq += v * v; }
        const float mu = sum * (1.0f / 128.0f), var = sq * (1.0f / 128.0f) - mu * mu;
        stat[(head * 128 + s) * 2] = mu; stat[(head * 128 + s) * 2 + 1] = rsqrtf(fmaxf(var, 0.f) + EPS);
    }
    __syncthreads();
    {
        const float* lng = p.in[14]; const float* lnb = p.in[15];
        for (int c = tid; c < 8192; c += NTHREADS) {
            const int hd = c >> 4, s0 = (c & 15) * 8, head = hd >> 7;
            u32x4 w = *(u32x4*)(GVT + (size_t)hd * 128 + s0);
            const float g = lng[hd], b = lnb[hd];
            float o[8];
            const unsigned ww[4] = {w.x, w.y, w.z, w.w};
#pragma unroll
            for (int i = 0; i < 4; ++i) {
                const float mu0 = stat[(head * 128 + s0 + 2 * i) * 2], r0 = stat[(head * 128 + s0 + 2 * i) * 2 + 1];
                const float mu1 = stat[(head * 128 + s0 + 2 * i + 1) * 2], r1 = stat[(head * 128 + s0 + 2 * i + 1) * 2 + 1];
                o[2 * i] = (bflo(ww[i]) - mu0) * r0 * g + b;
                o[2 * i + 1] = (bfhi(ww[i]) - mu1) * r1 * g + b;
            }
            *(u32x4*)(GVT + (size_t)hd * 128 + s0) = (u32x4){pk2(o[0], o[1]), pk2(o[2], o[3]), pk2(o[4], o[5]), pk2(o[6], o[7])};
        }
    }
    __syncthreads();
    STAMP(22);

    {
        const bf16_t* WSM = (const bf16_t*)(ws + WS_WSM);
        const float* bs = p.in[17];
        for (int head = 0; head < 4; ++head) {
            gemm_tile<128, true>(WSM + (size_t)head * 16384, 128, GVT + (size_t)head * 16384, 128, 128, lds, [=](int row, int col, f32x4 v) {
                const float b = bs[head * 128 + row];
                const u32x2 uu = *(const u32x2*)(UG + (size_t)row * 512 + head * 128 + col);
                const float y0 = bflo(uu.x) * (v[0] + b), y1 = bfhi(uu.x) * (v[1] + b), y2 = bflo(uu.y) * (v[2] + b), y3 = bfhi(uu.y) * (v[3] + b);
                *(u32x2*)(MIXA + (size_t)row * 1024 + 512 + head * 128 + col) = (u32x2){pk2(y0, y1), pk2(y2, y3)};
            });
        }
    }
    __syncthreads();
    STAMP(23);
    rows_rms512_inplace(MIXA + 512);
    STAMP(24);
    __syncthreads();
}

__device__ __forceinline__ void phaseS(const Params& p, LAS unsigned char* lds, int item) {
    int tid = threadIdx.x;
    asm volatile("" : "+v"(tid));
    const int lane = tid & 63, wave = tid >> 6, fr = lane & 15, fq = lane >> 4;
    unsigned char* ws = p.ws;
    const int g = item >> 3, pi = item & 7;
    const bf16_t* TTg = (const bf16_t*)(ws + WS_TT) + (size_t)g * 32768;
    const bf16_t* WSTg = (const bf16_t*)(ws + WS_WST) + (size_t)g * 16384;
    const float* PWg = (const float*)(ws + WS_PW) + (size_t)g * 17 * 128;
    LAS unsigned char* ltt = lds;
    LAS unsigned char* lsl = lds + 65536 + wave * 8192;
    LAS float* lst = (LAS float*)(lds + 131072);
#pragma unroll
    for (int i = 0; i < 8; ++i) {
        const int cid = tid + 512 * i, n = cid >> 5, c = cid & 31;
        const u32x4 v = *(const u32x4*)(TTg + (size_t)n * 256 + c * 8);
        *(LAS u32x4*)(ltt + n * 512 + ((c ^ (n & 15)) << 4)) = v;
    }
    const float a8r = PWg[128 + lane], a8i = PWg[128 + 64 + lane];
    const float a128r = PWg[16 * 128 + lane], a128i = PWg[16 * 128 + 64 + lane];
    float cr = 0.f, ci = 0.f;
    for (int r = 0; r < 4; ++r) {
        if ((r & 1) == 0) { cr = 0.f; ci = 0.f; }
        const int tile = ((2 * pi + (r >> 1)) << 4) + ((r & 1) << 3) + wave;
        unsigned char* arena = ws + WS_ARENA + (size_t)tile * ARENA_BYTES;
        const bf16_t* XS = (const bf16_t*)(arena + AR_XS) + (size_t)g * 2048;
        bf16_t* YS = (bf16_t*)(arena + AR_GV);
        const bf16_t* abase = XS + fr * 128 + fq * 8;
        f32x4 acc[8];
#pragma unroll
        for (int j = 0; j < 8; ++j) acc[j] = (f32x4){0.f, 0.f, 0.f, 0.f};
        bf16x8 afx[4];
#pragma unroll
        for (int ks = 0; ks < 4; ++ks) afx[ks] = *(const bf16x8*)(abase + ks * 32);
        {
            const bf16_t* bbase = WSTg + (size_t)fr * 128 + fq * 8;
#pragma unroll
            for (int ks = 0; ks < 4; ++ks)
#pragma unroll
                for (int j = 0; j < 8; ++j) {
                    const bf16x8 bfr = *(const bf16x8*)(bbase + (size_t)j * 16 * 128 + ks * 32);
                    acc[j] = __builtin_amdgcn_mfma_f32_16x16x32_bf16(bfr, afx[ks], acc[j], 0, 0, 0);
                }
        }
        __syncthreads();
#pragma unroll
        for (int j = 0; j < 8; ++j) *(LAS f32x4*)(lsl + fr * 512 + (16 * j + 4 * fq) * 4) = acc[j];
        LDS_WAIT();
        float sr[16], si[16], hlr[16], hli[16];
#pragma unroll
        for (int c = 0; c < 16; ++c) { sr[c] = *(LAS float*)(lsl + c * 512 + lane * 4); si[c] = *(LAS float*)(lsl + c * 512 + 256 + lane * 4); }
        float hr = 0.f, hi = 0.f;
#pragma unroll
        for (int c = 0; c < 16; ++c) {
            hlr[c] = hr; hli[c] = hi;
            const float nr = a8r * hr - a8i * hi + sr[c], ni = a8r * hi + a8i * hr + si[c];
            hr = nr; hi = ni;
        }
        lst[wave * 128 + lane] = hr; lst[wave * 128 + 64 + lane] = hi;
        __syncthreads();
        float Hr = cr, Hi = ci, Sr = 0.f, Si = 0.f;
#pragma unroll
        for (int w = 0; w < 8; ++w) {
            if (w == wave) { Sr = Hr; Si = Hi; }
            const float tr = lst[w * 128 + lane], ti = lst[w * 128 + 64 + lane];
            const float nr = a128r * Hr - a128i * Hi + tr, ni = a128r * Hi + a128i * Hr + ti;
            Hr = nr; Hi = ni;
        }
        cr = Hr; ci = Hi;
        {
            float pr = 1.f, pq = 0.f;
#pragma unroll
            for (int c = 0; c < 16; ++c) {
                const float vr = pr * Sr - pq * Si + hlr[c], vi = pr * Si + pq * Sr + hli[c];
                *(LAS bf16_t*)(lsl + c * 512 + ((((lane >> 3)) ^ c) << 4) + (lane & 7) * 2) = (bf16_t)f2bf(vr);
                *(LAS bf16_t*)(lsl + c * 512 + ((((64 + lane) >> 3) ^ c) << 4) + (lane & 7) * 2) = (bf16_t)f2bf(vi);
                const float nr = pr * a8r - pq * a8i, nq = pr * a8i + pq * a8r;
                pr = nr; pq = nq;
            }
        }
        LDS_WAIT();
#pragma unroll
        for (int j = 0; j < 8; ++j) acc[j] = (f32x4){0.f, 0.f, 0.f, 0.f};
#pragma unroll
        for (int ks = 0; ks < 8; ++ks) {
            bf16x8 af;
            if (ks < 4) af = afx[ks];
            else af = *(LAS bf16x8*)(lsl + fr * 512 + (((((ks - 4) * 4 + fq)) ^ fr) << 4));
#pragma unroll
            for (int j = 0; j < 8; ++j) {
                const int n = j * 16 + fr;
                const bf16x8 bfr = *(LAS bf16x8*)(ltt + n * 512 + (((ks * 4 + fq) ^ fr) << 4));
                acc[j] = __builtin_amdgcn_mfma_f32_16x16x32_bf16(bfr, af, acc[j], 0, 0, 0);
            }
        }
#pragma unroll
        for (int j = 0; j < 8; ++j) {
            const f32x4 v = acc[j];
            *(u32x2*)(YS + (size_t)(fr * 8 + j) * 512 + g * 16 + 4 * fq) = (u32x2){pk2(gelu_f(v[0]), gelu_f(v[1])), pk2(gelu_f(v[2]), gelu_f(v[3]))};
        }
    }
    __syncthreads();
}

__device__ __forceinline__ void final_rows(const Params& p, size_t tok0) {
    const int lane = threadIdx.x & 63, wave = threadIdx.x >> 6;
    const float4* g4 = (const float4*)p.in[29];
    float4 g[4];
#pragma unroll
    for (int j = 0; j < 4; ++j) g[j] = g4[lane + 64 * j];
    for (int rb = 0; rb < 16; rb += 4) {
        float4 v[4][4];
#pragma unroll
        for (int i = 0; i < 4; ++i) {
            const float4* hr = (const float4*)(p.out + (tok0 + wave * 16 + rb + i) * 1024);
#pragma unroll
            for (int j = 0; j < 4; ++j) v[i][j] = hr[lane + 64 * j];
        }
        asm volatile("" ::: "memory");
#pragma unroll
        for (int i = 0; i < 4; ++i) {
            float4* hr = (float4*)(p.out + (tok0 + wave * 16 + rb + i) * 1024);
            float ss = 0.f;
#pragma unroll
            for (int j = 0; j < 4; ++j) ss += v[i][j].x * v[i][j].x + v[i][j].y * v[i][j].y + v[i][j].z * v[i][j].z + v[i][j].w * v[i][j].w;
            ss = wave_sum(ss);
            const float rr = rsqrtf(ss * (1.0f / 1024.0f) + EPS);
#pragma unroll
            for (int j = 0; j < 4; ++j)
                hr[lane + 64 * j] = make_float4(v[i][j].x * rr * g[j].x, v[i][j].y * rr * g[j].y, v[i][j].z * rr * g[j].z, v[i][j].w * rr * g[j].w);
        }
    }
}

__device__ __forceinline__ unsigned ord_key(float f) { const unsigned u = __float_as_uint(f); return (u & 0x80000000u) ? ~u : (u | 0x80000000u); }
__device__ __forceinline__ float ord_val(unsigned k) { return (k & 0x80000000u) ? __uint_as_float(k & 0x7fffffffu) : __uint_as_float(~k); }

__device__ __forceinline__ void phase2(const Params& p, LAS unsigned char* lds, int tile) {
    int tid = threadIdx.x;
    asm volatile("" : "+v"(tid));
    const int lane = tid & 63, wave = tid >> 6;
    unsigned char* ws = p.ws;
    const size_t tok0 = (size_t)tile * TILE;
    unsigned char* arena = ws + WS_ARENA + (size_t)tile * ARENA_BYTES;
    bf16_t* HB = (bf16_t*)(ws + WS_HB) + tok0 * 1024;
    bf16_t* XS = (bf16_t*)(arena + AR_XS);
    float* HLOC = (float*)(arena + AR_HLOC);
    bf16_t* HI = (bf16_t*)(arena + AR_HI);
    bf16_t* YS = (bf16_t*)(arena + AR_GV);
    bf16_t* MIXA = (bf16_t*)(ws + WS_MIXA) + tok0 * 1024;
    float* OUT = p.out + tok0 * 1024;
    const float* x = p.in[0] + tok0 * 1024;
    LAS float* rs = (LAS float*)(lds + LDS_MISC);
    LAS float* rs2 = (LAS float*)(lds + LDS_MISC + 512);
    const float* PW = (const float*)(ws + WS_PW);

    {
        const bf16_t* WGLU = (const bf16_t*)(ws + WS_WGLU);
        const float* gb = p.in[13];
        for (int nc = 0; nc < 2; ++nc) {
            const int n0 = nc * 256;
            gemm_tile<256, true>(YS, 512, WGLU + (size_t)n0 * 512, 512, 512, lds, [=](int row, int col, f32x4 v) {
                const int gc = n0 + col;
                const u32x2 yy = *(const u32x2*)(YS + (size_t)row * 512 + gc);
                const float4 b = *(const float4*)(gb + gc);
                const float y0 = bflo(yy.x) * sigmoid_f(v[0] + b.x), y1 = bfhi(yy.x) * sigmoid_f(v[1] + b.y);
                const float y2 = bflo(yy.y) * sigmoid_f(v[2] + b.z), y3 = bfhi(yy.y) * sigmoid_f(v[3] + b.w);
                *(u32x2*)(MIXA + (size_t)row * 1024 + gc) = (u32x2){pk2(y0, y1), pk2(y2, y3)};
            });
        }
    }
    __syncthreads();
    STAMP(28);
    rows_rms512_inplace(MIXA);
    __syncthreads();
    STAMP(29);
    {
        const bf16_t* WOUT = (const bf16_t*)(ws + WS_WOUT);
        for (int nc = 0; nc < 4; ++nc) {
            const int n0 = nc * 256;
            gemm_tile<256, true>(MIXA, 1024, WOUT + (size_t)n0 * 1024, 1024, 1024, lds, [=](int row, int col, f32x4 v) {
                const float4 xx = *(const float4*)(x + (size_t)row * 1024 + n0 + col);
                *(float4*)(OUT + (size_t)row * 1024 + n0 + col) = make_float4(xx.x + v[0], xx.y + v[1], xx.z + v[2], xx.w + v[3]);
            });
        }
    }
    __syncthreads();
    STAMP(5);
    rows_cvt_rstd(OUT, HB, rs);
    __syncthreads();
    bf16_t* Q = (bf16_t*)(arena + AR_Q);
    {
        const bf16_t* WQ = (const bf16_t*)(ws + WS_WQ);
        for (int nc = 0; nc < 8; ++nc) {
            const int n0 = nc * 256;
            gemm_tile<256, true>(HB, 1024, WQ + (size_t)n0 * 1024, 1024, 1024, lds, [=](int row, int col, f32x4 v) {
                const float r = rs[row];
                *(u32x2*)(Q + (size_t)row * 2048 + n0 + col) = (u32x2){pk2(v[0] * r, v[1] * r), pk2(v[2] * r, v[3] * r)};
            });
        }
    }
    __syncthreads();
    STAMP(6);
    int* EIDX = (int*)(arena + AR_VNT);
    float* EGATE = (float*)(arena + AR_VNT + 65536);
    {
        const bf16_t* KEYS = (const bf16_t*)(ws + WS_KEYS);
        const int fr = lane & 15, fq = lane >> 4;
        const int wv = __builtin_amdgcn_readfirstlane(wave);
        LAS unsigned* lkey = (LAS unsigned*)(lds + 65536 + wv * 2048);
        const bf16_t* ksrc[4];
#pragma unroll
        for (int i = 0; i < 4; ++i) { const int row = 4 * (wv + 8 * i) + (lane >> 4); ksrc[i] = KEYS + (size_t)row * 128 + (((lane & 15) ^ (row & 15)) << 3); }
#define K_DMA(combo_, buf_) do { _Pragma("unroll") for (int i = 0; i < 4; ++i) \
        __builtin_amdgcn_global_load_lds((const __attribute__((address_space(1))) unsigned*)(ksrc[i] + (size_t)(combo_) * 16384), (LAS unsigned*)(lds + (buf_) * 32768 + (wv + 8 * i) * 1024), 16, 0, 0); } while (0)
        const bf16_t* qrow = Q + (size_t)(wv * 16 + fr) * 2048 + fq * 8;
        bf16x8 qa[4], qb[4];
        K_DMA(0, 0);
#pragma unroll
        for (int ks = 0; ks < 4; ++ks) qa[ks] = *(const bf16x8*)(qrow + ks * 32);
        unsigned S1[16];
#define CE(a_, b_) do { const unsigned hi_ = max(a_, b_), lo_ = min(a_, b_); a_ = hi_; b_ = lo_; } while (0)
#define SORT16(v_, o_) do { _Pragma("unroll") for (int p_ = 1; p_ < 16; p_ *= 2) _Pragma("unroll") for (int k_ = p_; k_ >= 1; k_ /= 2) \
        _Pragma("unroll") for (int j_ = k_ % p_; j_ <= 15 - k_; j_ += 2 * k_) _Pragma("unroll") for (int i_ = 0; i_ < k_; ++i_) \
            if (i_ + j_ + k_ <= 15 && (i_ + j_) / (2 * p_) == (i_ + j_ + k_) / (2 * p_)) CE(v_[(o_) + i_ + j_], v_[(o_) + i_ + j_ + k_]); } while (0)
#define BMERGE16(v_) do { _Pragma("unroll") for (int k_ = 8; k_ >= 1; k_ /= 2) _Pragma("unroll") for (int i_ = 0; i_ < 16; ++i_) \
        if ((i_ & k_) == 0) CE(v_[i_], v_[i_ + k_]); } while (0)
#define XMERGE16(v_, x_) do { unsigned o_[16]; _Pragma("unroll") for (int i_ = 0; i_ < 16; ++i_) o_[i_] = (unsigned)__shfl_xor((int)v_[15 - i_], x_); \
        _Pragma("unroll") for (int i_ = 0; i_ < 16; ++i_) v_[i_] = max(v_[i_], o_[i_]); BMERGE16(v_); } while (0)
        for (int head = 0; head < 8; ++head) {
#pragma unroll
            for (int kh = 0; kh < 2; ++kh) {
                const int combo = head * 2 + kh;
                asm volatile("s_waitcnt vmcnt(0)" ::: "memory");
                asm volatile("s_waitcnt lgkmcnt(0)" ::: "memory");
                __builtin_amdgcn_s_barrier();
                if (combo + 1 < 16) {
                    K_DMA(combo + 1, (combo + 1) & 1);
#pragma unroll
                    for (int ks = 0; ks < 4; ++ks) { if (kh == 0) qb[ks] = *(const bf16x8*)(qrow + (combo + 1) * 128 + ks * 32); else qa[ks] = *(const bf16x8*)(qrow + (combo + 1) * 128 + ks * 32); }
                }
                f32x4 acc[8];
#pragma unroll
                for (int j = 0; j < 8; ++j) acc[j] = (f32x4){0.f, 0.f, 0.f, 0.f};
                LAS unsigned char* kb = lds + (combo & 1) * 32768 + fr * 256;
#pragma unroll
                for (int ks = 0; ks < 4; ++ks) {
                    const bf16x8 af = (kh == 0) ? qa[ks] : qb[ks];
#pragma unroll
                    for (int j = 0; j < 8; ++j) {
                        const bf16x8 bfr = *(LAS bf16x8*)(kb + j * 16 * 256 + (((ks * 4 + fq) ^ fr) << 4));
                        acc[j] = __builtin_amdgcn_mfma_f32_16x16x32_bf16(bfr, af, acc[j], 0, 0, 0);
                    }
                }
                unsigned v[32];
#pragma unroll
                for (int j = 0; j < 8; ++j)
#pragma unroll
                    for (int r = 0; r < 4; ++r) v[4 * j + r] = (ord_key(acc[j][r]) & 0xFFFFFF80u) | (unsigned)(127 - (16 * j + 4 * fq + r));
                SORT16(v, 0);
                SORT16(v, 16);
                unsigned L[16];
#pragma unroll
                for (int i = 0; i < 16; ++i) L[i] = max(v[i], v[31 - i]);
                BMERGE16(L);
                XMERGE16(L, 16);
                XMERGE16(L, 32);
                if (kh == 0) {
#pragma unroll
                    for (int i = 0; i < 16; ++i) S1[i] = L[i];
                } else {
                    float s1[16], s2[16];
#pragma unroll
                    for (int i = 0; i < 16; ++i) { s1[i] = ord_val(S1[i] & 0xFFFFFF80u); s2[i] = ord_val(L[i] & 0xFFFFFF80u); }
                    unsigned c[16];
#pragma unroll
                    for (int i = 0; i < 16; ++i) c[i] = 0u;
                    {
                        int cnt = 0;
#pragma unroll
                        for (int a = 0; a < 16; ++a)
#pragma unroll
                            for (int b = 0; b < 16; ++b)
                                if ((a + 1) * (b + 1) <= 16) {
                                    const unsigned key = (ord_key(s1[a] + s2[b]) & 0xFFFFFF00u) | (unsigned)(255 - (a * 16 + b));
                                    if (fq == (cnt & 3)) c[cnt >> 2] = key;
                                    ++cnt;
                                }
                    }
                    SORT16(c, 0);
                    XMERGE16(c, 16);
                    XMERGE16(c, 32);
                    if (fq == 0) {
#pragma unroll
                        for (int i = 0; i < 4; ++i) {
                            *(LAS u32x4*)(lkey + fr * 32 + 4 * i) = (u32x4){S1[4 * i], S1[4 * i + 1], S1[4 * i + 2], S1[4 * i + 3]};
                            *(LAS u32x4*)(lkey + fr * 32 + 16 + 4 * i) = (u32x4){L[4 * i], L[4 * i + 1], L[4 * i + 2], L[4 * i + 3]};
                        }
                    }
                    float ev[16]; const float mx = ord_val(c[0] & 0xFFFFFF00u); float sum = 0.f;
#pragma unroll
                    for (int i = 0; i < 16; ++i) { ev[i] = __expf(ord_val(c[i] & 0xFFFFFF00u) - mx); sum += ev[i]; }
                    const float inv = 1.0f / sum;
                    LDS_WAIT();
                    int eo[4]; float go[4];
#pragma unroll
                    for (int i = 0; i < 4; ++i) {
                        const unsigned key = (fq == 0) ? c[i] : (fq == 1) ? c[4 + i] : (fq == 2) ? c[8 + i] : c[12 + i];
                        const float e = (fq == 0) ? ev[i] : (fq == 1) ? ev[4 + i] : (fq == 2) ? ev[8 + i] : ev[12 + i];
                        const int ab = 255 - (int)(key & 255u), a = ab >> 4, b = ab & 15;
                        const int i1 = 127 - (int)(lkey[fr * 32 + a] & 127u), i2 = 127 - (int)(lkey[fr * 32 + 16 + b] & 127u);
                        eo[i] = i1 * 128 + i2; go[i] = e * inv;
                    }
                    const int row = wv * 16 + fr;
                    *(int4*)(EIDX + (size_t)row * 128 + head * 16 + 4 * fq) = make_int4(eo[0], eo[1], eo[2], eo[3]);
                    *(float4*)(EGATE + (size_t)row * 128 + head * 16 + 4 * fq) = make_float4(go[0], go[1], go[2], go[3]);
                    LDS_WAIT();
                }
            }
        }
#undef K_DMA
    }
    __syncthreads();
    STAMP(8);
    if (tid < TILE) ((float*)(ws + WS_RSTD))[tok0 + tid] = rs[tid];
}

__device__ __forceinline__ void peer_u_item(const Params& p, int tile, int j) {
    int tid = threadIdx.x;
    asm volatile("" : "+v"(tid));
    const int lane = tid & 63, wave = tid >> 6, q = lane & 7, g = lane >> 3;
    unsigned char* ws = p.ws;
    const size_t tok0 = (size_t)tile * TILE;
    unsigned char* arena = ws + WS_ARENA + (size_t)tile * ARENA_BYTES;
    const bf16_t* HB = (const bf16_t*)(ws + WS_HB) + tok0 * 1024;
    const int* EIDX = (const int*)(arena + AR_VNT);
    float* PD = (float*)(arena + AR_Q);
    const unsigned char* U8 = ws + WS_UTAB + (size_t)j * 128 + q * 16;
    int idx[16];
    {
        const int* er = EIDX + (size_t)(wave * 16) * 128 + g;
#pragma unroll
        for (int it = 0; it < 16; ++it) idx[it] = er[8 * it];
    }
    for (int tt = 0; tt < 16; ++tt) {
        const int row = wave * 16 + tt;
        const u32x4 xa = *(const u32x4*)(HB + (size_t)row * 1024 + j * 128 + q * 16), xb = *(const u32x4*)(HB + (size_t)row * 1024 + j * 128 + q * 16 + 8);
        u32x4 w[16];
#pragma unroll
        for (int it = 0; it < 16; ++it) w[it] = *(const u32x4*)(U8 + (size_t)idx[it] * 1024);
        asm volatile("" ::: "memory");
        if (tt + 1 < 16) {
            const int* er = EIDX + (size_t)(row + 1) * 128 + g;
#pragma unroll
            for (int it = 0; it < 16; ++it) idx[it] = er[8 * it];
        }
        asm volatile("" ::: "memory");
        f32x2 x2[8];
        x2[0] = (f32x2){bflo(xa.x), bfhi(xa.x)}; x2[1] = (f32x2){bflo(xa.y), bfhi(xa.y)}; x2[2] = (f32x2){bflo(xa.z), bfhi(xa.z)}; x2[3] = (f32x2){bflo(xa.w), bfhi(xa.w)};
        x2[4] = (f32x2){bflo(xb.x), bfhi(xb.x)}; x2[5] = (f32x2){bflo(xb.y), bfhi(xb.y)}; x2[6] = (f32x2){bflo(xb.z), bfhi(xb.z)}; x2[7] = (f32x2){bflo(xb.w), bfhi(xb.w)};
        float r0 = 0.f, r1 = 0.f;
#pragma unroll
        for (int it = 0; it < 16; ++it) {
            f32x2 acc = {0.f, 0.f};
            acc = __builtin_amdgcn_cvt_pk_f32_fp8(w[it].x, false) * x2[0] + acc; acc = __builtin_amdgcn_cvt_pk_f32_fp8(w[it].x, true) * x2[1] + acc;
            acc = __builtin_amdgcn_cvt_pk_f32_fp8(w[it].y, false) * x2[2] + acc; acc = __builtin_amdgcn_cvt_pk_f32_fp8(w[it].y, true) * x2[3] + acc;
            acc = __builtin_amdgcn_cvt_pk_f32_fp8(w[it].z, false) * x2[4] + acc; acc = __builtin_amdgcn_cvt_pk_f32_fp8(w[it].z, true) * x2[5] + acc;
            acc = __builtin_amdgcn_cvt_pk_f32_fp8(w[it].w, false) * x2[6] + acc; acc = __builtin_amdgcn_cvt_pk_f32_fp8(w[it].w, true) * x2[7] + acc;
            float sdot = acc.x + acc.y;
            sdot += __builtin_bit_cast(float, __builtin_amdgcn_update_dpp(0, __builtin_bit_cast(int, sdot), 0xB1, 0xF, 0xF, true));
            sdot += __builtin_bit_cast(float, __builtin_amdgcn_update_dpp(0, __builtin_bit_cast(int, sdot), 0x4E, 0xF, 0xF, true));
            sdot += __builtin_bit_cast(float, __builtin_amdgcn_update_dpp(0, __builtin_bit_cast(int, sdot), 0x141, 0xF, 0xF, true));
            if (q == (it & 7)) { if (it < 8) r0 = sdot; else r1 = sdot; }
        }
        float* pd = PD + ((size_t)row * 8 + j) * 128 + 8 * q + g;
        pd[0] = r0; pd[64] = r1;
    }
}

__device__ __forceinline__ void peer_v_item(const Params& p, LAS unsigned char* lds, int tile, int j) {
    int tid = threadIdx.x;
    asm volatile("" : "+v"(tid));
    const int lane = tid & 63, wave = tid >> 6, q = lane & 7, g = lane >> 3;
    unsigned char* ws = p.ws;
    const size_t tok0 = (size_t)tile * TILE;
    unsigned char* arena = ws + WS_ARENA + (size_t)tile * ARENA_BYTES;
    bf16_t* HB = (bf16_t*)(ws + WS_HB) + tok0 * 1024;
    float* OUT = p.out + tok0 * 1024;
    const int* EIDX = (const int*)(arena + AR_VNT);
    const float* EGATE = (const float*)(arena + AR_VNT + 65536);
    const float* PD = (const float*)(arena + AR_Q);
    const float* RSTD = (const float*)(ws + WS_RSTD) + tok0;
    float* SSQ = (float*)(ws + WS_SSQ) + tok0 * 8;
    const unsigned char* V8 = ws + WS_VTAB + (size_t)j * 128 + q * 16;
    LAS float* actl = (LAS float*)(lds + wave * 512);
    int idx[16];
    float pd0[8], pd1[8], g0, g1, rsd;
    {
        const int row = wave * 16;
        const int* er = EIDX + (size_t)row * 128 + g;
#pragma unroll
        for (int it = 0; it < 16; ++it) idx[it] = er[8 * it];
#pragma unroll
        for (int jj = 0; jj < 8; ++jj) { pd0[jj] = PD[((size_t)row * 8 + jj) * 128 + lane]; pd1[jj] = PD[((size_t)row * 8 + jj) * 128 + 64 + lane]; }
        g0 = EGATE[(size_t)row * 128 + lane]; g1 = EGATE[(size_t)row * 128 + 64 + lane]; rsd = RSTD[row];
    }
    for (int tt = 0; tt < 16; ++tt) {
        const int row = wave * 16 + tt;
        u32x4 w[16];
#pragma unroll
        for (int it = 0; it < 16; ++it) w[it] = *(const u32x4*)(V8 + (size_t)idx[it] * 1024);
        asm volatile("" ::: "memory");
        {
            const float sc = rsd * (1.0f / 64.0f);
            float s0 = 0.f, s1 = 0.f;
#pragma unroll
            for (int jj = 0; jj < 8; ++jj) { s0 += pd0[jj]; s1 += pd1[jj]; }
            actl[lane] = gelu_f(s0 * sc) * g0 * 0.25f;
            actl[64 + lane] = gelu_f(s1 * sc) * g1 * 0.25f;
        }
        if (tt + 1 < 16) {
            const int* er = EIDX + (size_t)(row + 1) * 128 + g;
#pragma unroll
            for (int it = 0; it < 16; ++it) idx[it] = er[8 * it];
#pragma unroll
            for (int jj = 0; jj < 8; ++jj) { pd0[jj] = PD[((size_t)(row + 1) * 8 + jj) * 128 + lane]; pd1[jj] = PD[((size_t)(row + 1) * 8 + jj) * 128 + 64 + lane]; }
            g0 = EGATE[(size_t)(row + 1) * 128 + lane]; g1 = EGATE[(size_t)(row + 1) * 128 + 64 + lane]; rsd = RSTD[row + 1];
        }
        asm volatile("" ::: "memory");
        LDS_WAIT();
        f32x2 y2[8];
#pragma unroll
        for (int i = 0; i < 8; ++i) y2[i] = (f32x2){0.f, 0.f};
#pragma unroll
        for (int it = 0; it < 16; ++it) {
            const float a = actl[8 * it + g];
            const f32x2 a2 = {a, a};
            y2[0] = __builtin_amdgcn_cvt_pk_f32_fp8(w[it].x, false) * a2 + y2[0]; y2[1] = __builtin_amdgcn_cvt_pk_f32_fp8(w[it].x, true) * a2 + y2[1];
            y2[2] = __builtin_amdgcn_cvt_pk_f32_fp8(w[it].y, false) * a2 + y2[2]; y2[3] = __builtin_amdgcn_cvt_pk_f32_fp8(w[it].y, true) * a2 + y2[3];
            y2[4] = __builtin_amdgcn_cvt_pk_f32_fp8(w[it].z, false) * a2 + y2[4]; y2[5] = __builtin_amdgcn_cvt_pk_f32_fp8(w[it].z, true) * a2 + y2[5];
            y2[6] = __builtin_amdgcn_cvt_pk_f32_fp8(w[it].w, false) * a2 + y2[6]; y2[7] = __builtin_amdgcn_cvt_pk_f32_fp8(w[it].w, true) * a2 + y2[7];
        }
        LDS_WAIT();
        const bool b5 = (lane & 32) != 0, b4 = (lane & 16) != 0, b3 = (lane & 8) != 0;
        f32x2 k4[4];
#pragma unroll
        for (int i = 0; i < 4; ++i) {
            const f32x2 keep = b5 ? y2[4 + i] : y2[i], send = b5 ? y2[i] : y2[4 + i];
            k4[i] = (f32x2){keep.x + __shfl_xor(send.x, 32), keep.y + __shfl_xor(send.y, 32)};
        }
        f32x2 k2[2];
#pragma unroll
        for (int i = 0; i < 2; ++i) {
            const f32x2 keep = b4 ? k4[2 + i] : k4[i], send = b4 ? k4[i] : k4[2 + i];
            k2[i] = (f32x2){keep.x + __shfl_xor(send.x, 16), keep.y + __shfl_xor(send.y, 16)};
        }
        f32x2 yv;
        {
            const f32x2 keep = b3 ? k2[1] : k2[0], send = b3 ? k2[0] : k2[1];
            yv = (f32x2){keep.x + __shfl_xor(send.x, 8), keep.y + __shfl_xor(send.y, 8)};
        }
        const int col = j * 128 + q * 16 + (b5 ? 8 : 0) + (b4 ? 4 : 0) + (b3 ? 2 : 0);
        float* hp = OUT + (size_t)row * 1024 + col;
        const float2 h1 = *(const float2*)hp;
        const float h20 = h1.x + yv.x, h21 = h1.y + yv.y;
        *(float2*)hp = make_float2(h20, h21);
        *(unsigned*)(HB + (size_t)row * 1024 + col) = pk2(h20, h21);
        const float ss = wave_sum(h20 * h20 + h21 * h21);
        if (lane == 0) SSQ[row * 8 + j] = ss;
    }
}

__device__ __forceinline__ void phase5(const Params& p, LAS unsigned char* lds, int tile) {
    int tid = threadIdx.x;
    asm volatile("" : "+v"(tid));
    const int lane = tid & 63, wave = tid >> 6;
    unsigned char* ws = p.ws;
    const size_t tok0 = (size_t)tile * TILE;
    unsigned char* arena = ws + WS_ARENA + (size_t)tile * ARENA_BYTES;
    bf16_t* HB = (bf16_t*)(ws + WS_HB) + tok0 * 1024;
    float* OUT = p.out + tok0 * 1024;
    LAS float* rs2 = (LAS float*)(lds + LDS_MISC + 512);
    if (tid < TILE) {
        const float* sq = (const float*)(ws + WS_SSQ) + (tok0 + tid) * 8;
        float ss = 0.f;
#pragma unroll
        for (int jj = 0; jj < 8; ++jj) ss += sq[jj];
        rs2[tid] = rsqrtf(ss * (1.0f / 1024.0f) + EPS);
    }
    bf16_t* PB = (bf16_t*)(arena + AR_HI);
    {
        const float* pp = p.in[1] + tok0 * 256;
        for (int r = wave; r < TILE; r += 8) {
            const float4 v = *(const float4*)(pp + (size_t)r * 256 + lane * 4);
            *(u32x2*)(PB + (size_t)r * 256 + lane * 4) = (u32x2){pk2(v.x, v.y), pk2(v.z, v.w)};
        }
    }
    __syncthreads();
    bf16_t* PP = (bf16_t*)(arena + AR_PP);
    {
        const bf16_t* WPROJ = (const bf16_t*)(ws + WS_WPROJ);
        for (int nc = 0; nc < 4; ++nc) {
            const int n0 = nc * 256;
            gemm_tile<256, true>(PB, 256, WPROJ + (size_t)n0 * 256, 256, 256, lds, [=](int row, int col, f32x4 v) {
                *(u32x2*)(PP + (size_t)row * 1024 + n0 + col) = (u32x2){pk2(v[0], v[1]), pk2(v[2], v[3])};
            });
        }
    }
    __syncthreads();
    {
        const bf16_t* WGATE = (const bf16_t*)(ws + WS_WGATE);
        for (int nc = 0; nc < 4; ++nc) {
            const int n0 = nc * 256;
            gemm_tile<256, true>(HB, 1024, WGATE + (size_t)n0 * 1024, 1024, 1024, lds, [=](int row, int col, f32x4 v) {
                const float r = rs2[row];
                const u32x2 pv = *(const u32x2*)(PP + (size_t)row * 1024 + n0 + col);
                float4 h = *(const float4*)(OUT + (size_t)row * 1024 + n0 + col);
                h.x += sigmoid_f(v[0] * r) * bflo(pv.x); h.y += sigmoid_f(v[1] * r) * bfhi(pv.x);
                h.z += sigmoid_f(v[2] * r) * bflo(pv.y); h.w += sigmoid_f(v[3] * r) * bfhi(pv.y);
                *(float4*)(OUT + (size_t)row * 1024 + n0 + col) = h;
            });
        }
    }
    __syncthreads();
    STAMP(10);
    final_rows(p, tok0);
    __syncthreads();
    STAMP(11);
}

#define XB_TMO      128
#define XB_XCNT(j)  (256  + 64 * (j))
#define XB_XSUB(j)  (1280 + 64 * (j))
#define XB_XGEN(j)  (2304 + 64 * (j))
#define XB_TOP      3328
#define XB_TOPGEN   3392
#define XCD_BAR_WORDS 3456
#define XB_SPIN_CAP (1u << 22)
__device__ __forceinline__ unsigned xb_ld(unsigned* p)              { return __hip_atomic_load(p, __ATOMIC_RELAXED, __HIP_MEMORY_SCOPE_AGENT); }
__device__ __forceinline__ unsigned xb_add(unsigned* p, unsigned v) { return __hip_atomic_fetch_add(p, v, __ATOMIC_RELAXED, __HIP_MEMORY_SCOPE_AGENT); }
__device__ __forceinline__ unsigned xb_xcc_id() { return (unsigned)__builtin_amdgcn_s_getreg((3 << 11) | 20) & 0xFu; }
#define XB_SPIN(cond, bar) do { unsigned _sp = 0; while (cond) { __builtin_amdgcn_s_sleep(1); \
    if ((++_sp & 255u) == 0u) { if (xb_ld(&(bar)[XB_TMO])) break; if (_sp > XB_SPIN_CAP) { atomicAdd(&(bar)[XB_TMO], 1u); break; } } } } while (0)
struct XcdBarrier { unsigned* bar; unsigned x; volatile LAS unsigned* st; };
__device__ __forceinline__ XcdBarrier xcd_barrier_post(unsigned* bar, volatile LAS unsigned* st) {
    XcdBarrier b; b.bar = bar; b.x = xb_xcc_id(); b.st = st;
    if (threadIdx.x == 0) (void)xb_add(&bar[XB_XCNT(b.x)], 1u);
    return b;
}
__device__ __forceinline__ void xcd_barrier_complete(unsigned* bar, unsigned x, unsigned& nloc, unsigned& nx) {
    const unsigned G = gridDim.x * gridDim.y * gridDim.z;
    unsigned sum, cnt, mine, sp = 0u;
    for (;;) {
        sum = 0u; cnt = 0u; mine = 0u;
#pragma unroll
        for (unsigned j = 0; j < 16; ++j) { const unsigned c = xb_ld(&bar[XB_XCNT(j)]); sum += c; cnt += (c > 0u) ? 1u : 0u; mine = (j == x) ? c : mine; }
        if (sum == G) break;
        __builtin_amdgcn_s_sleep(1);
        if ((++sp & 255u) == 0u) { if (xb_ld(&bar[XB_TMO])) break; if (sp > XB_SPIN_CAP) { atomicAdd(&bar[XB_TMO], 1u); break; } }
    }
    nloc = mine > 0u ? mine : 1u; nx = cnt > 0u ? cnt : 1u;
}
__device__ __forceinline__ void xcd_barrier(const XcdBarrier& b) {
    asm volatile("s_waitcnt vmcnt(0)" ::: "memory");
    __syncthreads();
    if (threadIdx.x == 0) {
        unsigned* bar = b.bar;
        __builtin_amdgcn_s_waitcnt(0);
        unsigned nloc = b.st[0], nx = b.st[1];
        if (nloc == 0u) { xcd_barrier_complete(bar, b.x, nloc, nx); b.st[0] = nloc; b.st[1] = nx; }
        const unsigned old = xb_add(&bar[XB_XSUB(b.x)], 1u);
        const unsigned gen = old / nloc;
        if (old + 1u == (gen + 1u) * nloc) {
            __builtin_amdgcn_fence(__ATOMIC_RELEASE, "agent");
            asm volatile("s_waitcnt vmcnt(0)" ::: "memory");
            const unsigned og = xb_add(&bar[XB_TOP], 1u);
            const unsigned tg = og / nx;
            if (og + 1u == (tg + 1u) * nx) xb_add(&bar[XB_TOPGEN], 1u);
            else XB_SPIN(xb_ld(&bar[XB_TOPGEN]) == tg, bar);
            __builtin_amdgcn_fence(__ATOMIC_ACQUIRE, "agent");
            xb_add(&bar[XB_XGEN(b.x)], 1u);
            asm volatile("s_waitcnt vmcnt(0)" ::: "memory");
        } else {
            XB_SPIN(xb_ld(&bar[XB_XGEN(b.x)]) == gen, bar);
            __builtin_amdgcn_fence(__ATOMIC_ACQUIRE, "agent");
            asm volatile("s_waitcnt vmcnt(0)" ::: "memory");
        }
    }
    __syncthreads();
}

__global__ void __launch_bounds__(NTHREADS) fwd_kernel(Params p) {
    __shared__ __attribute__((aligned(16))) unsigned char lds_raw[LDS_BYTES];
    LAS unsigned char* lds = (LAS unsigned char*)lds_raw;
    cg::grid_group grid = cg::this_grid();
    volatile LAS unsigned* bst = (volatile LAS unsigned*)(lds + LDS_MISC + 1024);
    if (threadIdx.x == 0) { bst[0] = 0u; bst[1] = 0u; }
    __syncthreads();
    XcdBarrier bar = xcd_barrier_post((unsigned*)(p.ws + WS_BAR), bst);
    STAMP(0);
#ifdef PROBE_A
    if (blockIdx.x == 0 && threadIdx.x == 0) *(unsigned*)(p.ws + WS_END) = 0u;
#endif
    phase0(p, lds);
    STAMP(1);
    grid.sync();
    STAMP(2);
    for (int tile = blockIdx.x; tile < NTILES; tile += gridDim.x) phase1(p, lds, tile);
    STAMP(3);
    xcd_barrier(bar);
    STAMP(4);
    for (int it = blockIdx.x; it < NG * 8; it += gridDim.x) phaseS(p, lds, it);
    STAMP(18);
    xcd_barrier(bar);
    STAMP(19);
    for (int tile = blockIdx.x; tile < NTILES; tile += gridDim.x) phase2(p, lds, tile);
    STAMP(12);
    xcd_barrier(bar);
    STAMP(13);
    for (int it = blockIdx.x; it < NTILES * 8; it += gridDim.x) peer_u_item(p, it >> 3, it & 7);
    STAMP(14);
    xcd_barrier(bar);
    STAMP(15);
    for (int it = blockIdx.x; it < NTILES * 8; it += gridDim.x) peer_v_item(p, lds, it >> 3, it & 7);
    STAMP(16);
    xcd_barrier(bar);
    STAMP(17);
    for (int tile = blockIdx.x; tile < NTILES; tile += gridDim.x) phase5(p, lds, tile);
#ifdef PROBE_A
    {
        LAS unsigned long long* ts = (LAS unsigned long long*)(lds + LDS_MISC + 2048);
        unsigned* mx = (unsigned*)(p.ws + WS_END);
        if (threadIdx.x == 0) atomicMax(mx, (unsigned)(ts[PROBE_B] - ts[PROBE_A]));
        grid.sync();
        if (blockIdx.x == 0 && threadIdx.x == 0) {
            const unsigned long long dly = (unsigned long long)__hip_atomic_load(mx, __ATOMIC_RELAXED, __HIP_MEMORY_SCOPE_AGENT) * PROBE_MUL, t_end = __builtin_amdgcn_s_memrealtime();
            while (__builtin_amdgcn_s_memrealtime() - t_end < dly) __builtin_amdgcn_s_sleep(8);
        }
    }
#endif
}

extern "C" void kernel_launch(void* const* d_in, const int* in_sizes, int n_in, void* d_out, int out_size, void* d_ws, size_t ws_size,
                              hipStream_t stream) {
    static int grid_blocks = 0;
    if (!grid_blocks) {
        int dev = 0, cus = 0, per_cu = 0;
        (void)hipGetDevice(&dev);
        (void)hipDeviceGetAttribute(&cus, hipDeviceAttributeMultiprocessorCount, dev);
        (void)hipOccupancyMaxActiveBlocksPerMultiprocessor(&per_cu, fwd_kernel, NTHREADS, 0);
        if (per_cu < 1) { fprintf(stderr, "kernel_launch: occupancy query says %d blocks per CU\n", per_cu); per_cu = 1; }
        grid_blocks = cus * 1;
        if (grid_blocks > NTILES) grid_blocks = NTILES;
        if (ws_size < WS_END) fprintf(stderr, "kernel_launch: workspace too small: %zu < %zu\n", ws_size, (size_t)WS_END);
        fprintf(stderr, "kernel_launch: cus=%d per_cu=%d grid=%d ws=%zu need=%zu\n", cus, per_cu, grid_blocks, ws_size, (size_t)WS_END);
    }
    (void)hipMemsetAsync((unsigned char*)d_ws + WS_BAR, 0, 16384, stream);
    Params p{};
    for (int i = 0; i < 30; ++i) p.in[i] = (const float*)d_in[i];
    p.out = (float*)d_out;
    p.ws = (unsigned char*)d_ws;
    void* args[] = {&p};
    hipError_t e = hipLaunchCooperativeKernel((void*)fwd_kernel, dim3(grid_blocks), dim3(NTHREADS), args, 0, stream);
    if (e != hipSuccess) fprintf(stderr, "cooperative launch failed: %s (grid %d)\n", hipGetErrorString(e), grid_blocks);
}
```

```cpp
#include <hip/hip_runtime.h>
#include <hip/hip_cooperative_groups.h>
#include <cstdio>
#include <cstdint>
namespace cg = cooperative_groups;


#define LAS __attribute__((address_space(3)))
typedef unsigned short bf16_t;
typedef short bf16x8 __attribute__((ext_vector_type(8)));
typedef float f32x4 __attribute__((ext_vector_type(4)));
typedef float f32x2 __attribute__((ext_vector_type(2)));
typedef unsigned u32x4 __attribute__((ext_vector_type(4)));
typedef unsigned u32x2 __attribute__((ext_vector_type(2)));

constexpr int T_TOK = 16 * 2048, SEQ = 2048, D = 1024, DIN = 1536;
constexpr int NG = 32;
constexpr int TILE = 128, NTILES = T_TOK / TILE, TPS = SEQ / TILE;
constexpr float EPS = 1e-6f;
constexpr int NTHREADS = 512;

constexpr size_t WS_WIN = 0;
constexpr size_t WS_WGLU = WS_WIN + (size_t)1536 * 1024 * 2;
constexpr size_t WS_WOUT = WS_WGLU + (size_t)512 * 512 * 2;
constexpr size_t WS_WQ = WS_WOUT + (size_t)1024 * 1024 * 2;
constexpr size_t WS_KEYS = WS_WQ + (size_t)2048 * 1024 * 2;
constexpr size_t WS_WGATE = WS_KEYS + (size_t)16 * 128 * 128 * 2;
constexpr size_t WS_WPROJ = WS_WGATE + (size_t)1024 * 1024 * 2;
constexpr size_t WS_WSM = WS_WPROJ + (size_t)1024 * 256 * 2;
constexpr size_t WS_TT = WS_WSM + (size_t)4 * 128 * 128 * 2;
constexpr size_t WS_WST = WS_TT + (size_t)32 * 128 * 256 * 2;
constexpr size_t WS_PW = WS_WST + (size_t)32 * 128 * 128 * 2;
constexpr size_t WS_STILE = WS_PW + (size_t)32 * 17 * 128 * 4;
constexpr size_t WS_UTAB = WS_STILE + (size_t)256 * 32 * 128 * 4;
constexpr size_t WS_VTAB = WS_UTAB + (size_t)16384 * 1024;
constexpr size_t WS_RSTD = WS_VTAB + (size_t)16384 * 1024;
constexpr size_t WS_SSQ = WS_RSTD + (size_t)T_TOK * 4;
constexpr size_t WS_BAR = WS_SSQ + (size_t)T_TOK * 8 * 4;
constexpr size_t WS_MIXA = WS_BAR + 16384;
constexpr size_t WS_HB = WS_MIXA + (size_t)T_TOK * 1024 * 2;
constexpr size_t WS_ARENA = WS_HB + (size_t)T_TOK * 1024 * 2;
constexpr size_t AR_XS = 0;
constexpr size_t AR_HLOC = 131072;
constexpr size_t AR_UG = 393216;
constexpr size_t AR_Q = 0;
constexpr size_t AR_PP = 0;
constexpr size_t AR_GV = 524288;
constexpr size_t AR_VNT = 655360;
constexpr size_t AR_HI = 786432;
constexpr size_t ARENA_BYTES = 917504;
constexpr size_t WS_END = WS_ARENA + (size_t)NTILES * ARENA_BYTES;

constexpr int LDS_MISC = 147456;
constexpr int LDS_BYTES = LDS_MISC + 4096;

struct Params {
    const float* in[30];
    float* out;
    unsigned char* ws;
};

typedef __bf16 bf16v2 __attribute__((ext_vector_type(2)));
__device__ __forceinline__ unsigned pk2(float lo, float hi) {
    const f32x2 v = {lo, hi};
    return __builtin_bit_cast(unsigned, __builtin_convertvector(v, bf16v2));
}
__device__ __forceinline__ unsigned f2bf(float f) { return pk2(f, 0.f) & 0xffffu; }
__device__ __forceinline__ float bflo(unsigned w) { return __uint_as_float(w << 16); }
__device__ __forceinline__ float bfhi(unsigned w) { return __uint_as_float(w & 0xffff0000u); }
__device__ __forceinline__ float bf2f(bf16_t b) { return __uint_as_float((unsigned)b << 16); }
#define DPP_F(v, ctrl) __builtin_bit_cast(float, __builtin_amdgcn_update_dpp(0, __builtin_bit_cast(int, (v)), (ctrl), 0xF, 0xF, true))
__device__ __forceinline__ float wave_sum(float v) {
#pragma unroll
    for (int o = 1; o < 64; o <<= 1) v += __shfl_xor(v, o);
    return v;
}
__device__ __forceinline__ float gelu_f(float v) {
    const float av = fabsf(v);
    const float t = __builtin_amdgcn_rcpf(av * 0.2316418882f + 1.0f);
    float q = t * 0.5307027145f + (-0.7265760135f);
    q = q * t + 0.7107068705f; q = q * t + (-0.142248368f); q = q * t + 0.127414796f; q = q * t;
    const float e = __builtin_amdgcn_exp2f(v * v * (-0.72134752044f));
    const float m = v * (q * e);
    return v < 0.f ? m : v - m;
}
__device__ __forceinline__ float sigmoid_f(float x) {
    return __builtin_amdgcn_rcpf(1.0f + __builtin_amdgcn_exp2f(x * (-1.44269504089f)));
}
#define LDS_WAIT() asm volatile("s_waitcnt lgkmcnt(0)" ::: "memory")
#ifdef PROBE_A
#define STAMP(i) do { if (threadIdx.x == 0) ((LAS unsigned long long*)(lds + LDS_MISC + 2048))[i] = __builtin_amdgcn_s_memrealtime(); } while (0)
#else
#define STAMP(i) do { } while (0)
#endif

template <int BN, bool TR, int DIAG = 0, class Epi>
__device__ __forceinline__ void gemm_tile(const bf16_t* __restrict__ A, int lda, const bf16_t* __restrict__ Bt, int ldb, int K,
                                          LAS unsigned char* lds, const Epi& epi) {
    constexpr int NT = BN / 64;
    constexpr int NPB = BN / 64;
    constexpr int NP = 2 + NPB;
    constexpr int A_BYTES = 128 * 128;
    constexpr int B_BYTES = BN * 128;
    constexpr int STAGE = A_BYTES + B_BYTES;
    constexpr int A_AUX = 0;
    int tid = threadIdx.x;
    asm volatile("" : "+v"(tid));
    const int lane = tid & 63, wave = __builtin_amdgcn_readfirstlane(tid >> 6), wm = wave >> 2, wn = wave & 3;
    f32x4 acc[4][NT];
#pragma unroll
    for (int i = 0; i < 4; ++i)
#pragma unroll
        for (int j = 0; j < NT; ++j) acc[i][j] = (f32x4){0.f, 0.f, 0.f, 0.f};
    const int prow = lane >> 3;
    const bf16_t* asrc[2]; const bf16_t* bsrc[NPB];
#pragma unroll
    for (int i = 0; i < 2; ++i) { const int row = 8 * (wave + 8 * i) + prow; asrc[i] = A + (size_t)row * lda + (((lane & 7) ^ ((row >> 1) & 7)) << 3); }
#pragma unroll
    for (int i = 0; i < NPB; ++i) { const int row = 8 * (wave + 8 * i) + prow; bsrc[i] = Bt + (size_t)row * ldb + (((lane & 7) ^ ((row >> 1) & 7)) << 3); }
    const int KT = K / 64;
    const int fr = lane & 15, fq = lane >> 4;
    const int fsw = (lane >> 1) & 7;
#define G_DMA(kt_, st_) do { const int k0_ = (DIAG == 1) ? 0 : (kt_) * 64; LAS unsigned char* sb_ = lds + (st_) * STAGE; \
        _Pragma("unroll") for (int i = 0; i < 2; ++i) __builtin_amdgcn_global_load_lds((const __attribute__((address_space(1))) unsigned*)(asrc[i] + k0_), (LAS unsigned*)(sb_ + (wave + 8 * i) * 1024), 16, 0, A_AUX); \
        _Pragma("unroll") for (int i = 0; i < NPB; ++i) __builtin_amdgcn_global_load_lds((const __attribute__((address_space(1))) unsigned*)(bsrc[i] + k0_), (LAS unsigned*)(sb_ + A_BYTES + (wave + 8 * i) * 1024), 16, 0, 0); } while (0)
    G_DMA(0, 0);
    if (KT > 1) G_DMA(1, 1);
    int st = 0;
    for (int kt = 0; kt < KT; ++kt) {
        if (kt + 1 < KT) asm volatile("s_waitcnt vmcnt(%0)" :: "n"(NP) : "memory");
        else asm volatile("s_waitcnt vmcnt(0)" ::: "memory");
        asm volatile("s_waitcnt lgkmcnt(0)" ::: "memory");
        __builtin_amdgcn_s_barrier();
        if (kt + 2 < KT) { const int st2 = (st >= 1) ? st - 1 : 2; G_DMA(kt + 2, st2); }
        LAS unsigned char* la = lds + st * STAGE + (wm * 64 + fr) * 128;
        LAS unsigned char* lb = lds + st * STAGE + A_BYTES + (wn * (BN / 4) + fr) * 128;
#pragma unroll
        for (int kk = 0; kk < 2; ++kk) {
            const int choff = ((kk * 4 + fq) ^ fsw) << 4;
            bf16x8 af[4], bfr[NT];
#pragma unroll
            for (int i = 0; i < 4; ++i) af[i] = *(LAS bf16x8*)(la + i * 16 * 128 + choff);
#pragma unroll
            for (int j = 0; j < NT; ++j) bfr[j] = *(LAS bf16x8*)(lb + j * 16 * 128 + choff);
#pragma unroll
            for (int i = 0; i < 4; ++i)
#pragma unroll
                for (int j = 0; j < NT; ++j) {
                    if (TR) acc[i][j] = __builtin_amdgcn_mfma_f32_16x16x32_bf16(bfr[j], af[i], acc[i][j], 0, 0, 0);
                    else    acc[i][j] = __builtin_amdgcn_mfma_f32_16x16x32_bf16(af[i], bfr[j], acc[i][j], 0, 0, 0);
                }
        }
        st = (st == 2) ? 0 : st + 1;
    }
#undef G_DMA
    asm volatile("s_waitcnt lgkmcnt(0)" ::: "memory");
    __builtin_amdgcn_s_barrier();
#pragma unroll
    for (int i = 0; i < 4; ++i)
#pragma unroll
        for (int j = 0; j < NT; ++j) {
            if (TR) epi(wm * 64 + i * 16 + fr, wn * (BN / 4) + j * 16 + 4 * fq, acc[i][j]);
            else    epi(wm * 64 + i * 16 + 4 * fq, wn * (BN / 4) + j * 16 + fr, acc[i][j]);
        }
}

template <int BN, bool TR, int DIAG = 0, class Epi>
__device__ __forceinline__ void gemm_stream(const bf16_t* __restrict__ A, int lda, size_t a_cs, const bf16_t* __restrict__ Bt, int ldb, size_t b_cs,
                                            int K, int nchunks, LAS unsigned char* lds, const Epi& epi) {
    constexpr int NT = BN / 64;
    constexpr int NPB = BN / 64;
    constexpr int NP = 2 + NPB;
    constexpr int A_BYTES = 128 * 128;
    constexpr int B_BYTES = BN * 128;
    constexpr int STAGE = A_BYTES + B_BYTES;
    int tid = threadIdx.x;
    asm volatile("" : "+v"(tid));
    const int lane = tid & 63, wave = __builtin_amdgcn_readfirstlane(tid >> 6), wm = wave >> 2, wn = wave & 3;
    const int prow = lane >> 3;
    const bf16_t* asrc[2]; const bf16_t* bsrc[NPB];
#pragma unroll
    for (int i = 0; i < 2; ++i) { const int row = 8 * (wave + 8 * i) + prow; asrc[i] = A + (size_t)row * lda + (((lane & 7) ^ ((row >> 1) & 7)) << 3); }
#pragma unroll
    for (int i = 0; i < NPB; ++i) { const int row = 8 * (wave + 8 * i) + prow; bsrc[i] = Bt + (size_t)row * ldb + (((lane & 7) ^ ((row >> 1) & 7)) << 3); }
    const int KT = K / 64, NTILE = KT * nchunks;
    const int fr = lane & 15, fq = lane >> 4, fsw = (lane >> 1) & 7;
    const int aoff = (wm * 64 + fr) * 128, boff = A_BYTES + (wn * (BN / 4) + fr) * 128;
    int d_kt = 0, d_st = 0;
    int d_issued = 0;
#define GS_DMA() do { if (d_issued < NTILE && !(DIAG == 4 && d_issued >= 3)) { const int k0_ = (DIAG == 1) ? 0 : d_kt * 64; LAS unsigned char* sb_ = lds + d_st * STAGE; \
        _Pragma("unroll") for (int i = 0; i < 2; ++i) __builtin_amdgcn_global_load_lds((const __attribute__((address_space(1))) unsigned*)(asrc[i] + k0_), (LAS unsigned*)(sb_ + (wave + 8 * i) * 1024), 16, 0, 0); \
        _Pragma("unroll") for (int i = 0; i < NPB; ++i) __builtin_amdgcn_global_load_lds((const __attribute__((address_space(1))) unsigned*)(bsrc[i] + k0_), (LAS unsigned*)(sb_ + A_BYTES + (wave + 8 * i) * 1024), 16, 0, 0); \
        ++d_issued; d_st = (d_st == 2) ? 0 : d_st + 1; \
        if (++d_kt == KT) { d_kt = 0; _Pragma("unroll") for (int i = 0; i < 2; ++i) asrc[i] += a_cs; _Pragma("unroll") for (int i = 0; i < NPB; ++i) bsrc[i] += b_cs; } } } while (0)
#define GS_READ(AF, BF, st_, kk_) do { if (DIAG == 3) break; const int ch_ = (((kk_) * 4 + fq) ^ fsw) << 4; LAS unsigned char* sb_ = lds + (st_) * STAGE; \
        _Pragma("unroll") for (int i = 0; i < 4; ++i) AF[i] = *(LAS bf16x8*)(sb_ + aoff + i * 16 * 128 + ch_); \
        _Pragma("unroll") for (int j = 0; j < NT; ++j) BF[j] = *(LAS bf16x8*)(sb_ + boff + j * 16 * 128 + ch_); } while (0)
#define GS_MMA(AF, BF) do { if (DIAG == 2 || DIAG == 3) { _Pragma("unroll") for (int i = 0; i < 4; ++i) asm volatile("" :: "v"(AF[i])); _Pragma("unroll") for (int j = 0; j < NT; ++j) asm volatile("" :: "v"(BF[j])); break; } _Pragma("unroll") for (int i = 0; i < 4; ++i) _Pragma("unroll") for (int j = 0; j < NT; ++j) { \
        if (TR) acc[i][j] = __builtin_amdgcn_mfma_f32_16x16x32_bf16(BF[j], AF[i], acc[i][j], 0, 0, 0); \
        else    acc[i][j] = __builtin_amdgcn_mfma_f32_16x16x32_bf16(AF[i], BF[j], acc[i][j], 0, 0, 0); } } while (0)
    f32x4 acc[4][NT];
#pragma unroll
    for (int i = 0; i < 4; ++i)
#pragma unroll
        for (int j = 0; j < NT; ++j) acc[i][j] = (f32x4){0.f, 0.f, 0.f, 0.f};
    GS_DMA(); GS_DMA(); GS_DMA();
    if (NTILE >= 3) asm volatile("s_waitcnt vmcnt(%0)" :: "n"(2 * NP) : "memory");
    else if (NTILE == 2) asm volatile("s_waitcnt vmcnt(%0)" :: "n"(NP) : "memory");
    else asm volatile("s_waitcnt vmcnt(0)" ::: "memory");
    asm volatile("s_waitcnt lgkmcnt(0)" ::: "memory");
    __builtin_amdgcn_s_barrier();
    bf16x8 fa0[4] = {}, fb0[NT] = {}, fa1[4] = {}, fb1[NT] = {};
    GS_READ(fa0, fb0, 0, 0);
    int st = 0, kt = 0, chunk = 0;
    for (int t = 0; t < NTILE; ++t) {
        GS_READ(fa1, fb1, st, 1);
        GS_MMA(fa0, fb0);
        if (t + 2 < NTILE) asm volatile("s_waitcnt vmcnt(%0)" :: "n"(NP) : "memory");
        else asm volatile("s_waitcnt vmcnt(0)" ::: "memory");
        asm volatile("s_waitcnt lgkmcnt(0)" ::: "memory");
        __builtin_amdgcn_s_barrier();
        GS_DMA();
        const int stn = (st == 2) ? 0 : st + 1;
        if (t + 1 < NTILE) GS_READ(fa0, fb0, stn, 0);
        GS_MMA(fa1, fb1);
        st = stn;
        if (++kt == KT) {
            kt = 0;
#pragma unroll
            for (int i = 0; i < 4; ++i)
#pragma unroll
                for (int j = 0; j < NT; ++j) {
                    if (TR) epi(chunk, wm * 64 + i * 16 + fr, wn * (BN / 4) + j * 16 + 4 * fq, acc[i][j]);
                    else    epi(chunk, wm * 64 + i * 16 + 4 * fq, wn * (BN / 4) + j * 16 + fr, acc[i][j]);
                    acc[i][j] = (f32x4){0.f, 0.f, 0.f, 0.f};
                }
            ++chunk;
        }
    }
#undef GS_DMA
#undef GS_READ
#undef GS_MMA
}

__device__ __forceinline__ void rows_cvt_rstd(const float* __restrict__ src, bf16_t* __restrict__ dst, LAS float* rs) {
    int tid_ = threadIdx.x;
    asm volatile("" : "+v"(tid_));
    const int lane = tid_ & 63, wave = tid_ >> 6;
    for (int rb = 0; rb < 16; rb += 4) {
        float4 a[4][4];
#pragma unroll
        for (int i = 0; i < 4; ++i) {
            const float4* xr = (const float4*)(src + (size_t)(wave * 16 + rb + i) * 1024);
#pragma unroll
            for (int j = 0; j < 2; ++j) { a[i][2 * j] = xr[lane * 2 + 128 * j]; a[i][2 * j + 1] = xr[lane * 2 + 1 + 128 * j]; }
        }
        asm volatile("" ::: "memory");
#pragma unroll
        for (int i = 0; i < 4; ++i) {
            const int r = wave * 16 + rb + i;
            float ss = 0.f;
#pragma unroll
            for (int j = 0; j < 2; ++j) {
                const float4 u = a[i][2 * j], v = a[i][2 * j + 1];
                ss += u.x * u.x + u.y * u.y + u.z * u.z + u.w * u.w + v.x * v.x + v.y * v.y + v.z * v.z + v.w * v.w;
                *(u32x4*)(dst + (size_t)r * 1024 + lane * 8 + 512 * j) = (u32x4){pk2(u.x, u.y), pk2(u.z, u.w), pk2(v.x, v.y), pk2(v.z, v.w)};
            }
            ss = wave_sum(ss);
            if (lane == 0) rs[r] = rsqrtf(ss * (1.0f / 1024.0f) + EPS);
        }
    }
}
__device__ __forceinline__ void rows_rms512_inplace(bf16_t* base) {
    int tid_ = threadIdx.x;
    asm volatile("" : "+v"(tid_));
    const int lane = tid_ & 63, wave = tid_ >> 6;
    for (int rb = 0; rb < 16; rb += 8) {
        u32x4 w[8];
#pragma unroll
        for (int i = 0; i < 8; ++i) w[i] = *(const u32x4*)(base + (size_t)(wave * 16 + rb + i) * 1024 + lane * 8);
        asm volatile("" ::: "memory");
#pragma unroll
        for (int i = 0; i < 8; ++i) {
            const float f0 = bflo(w[i].x), f1 = bfhi(w[i].x), f2 = bflo(w[i].y), f3 = bfhi(w[i].y), f4 = bflo(w[i].z), f5 = bfhi(w[i].z), f6 = bflo(w[i].w), f7 = bfhi(w[i].w);
            float ss = f0 * f0 + f1 * f1 + f2 * f2 + f3 * f3 + f4 * f4 + f5 * f5 + f6 * f6 + f7 * f7;
            ss = wave_sum(ss);
            const float rr = rsqrtf(ss * (1.0f / 512.0f) + EPS);
            *(u32x4*)(base + (size_t)(wave * 16 + rb + i) * 1024 + lane * 8) = (u32x4){pk2(f0 * rr, f1 * rr), pk2(f2 * rr, f3 * rr), pk2(f4 * rr, f5 * rr), pk2(f6 * rr, f7 * rr)};
        }
    }
}

__device__ __forceinline__ void transpose_item(const float* __restrict__ W, int K, int N, bf16_t* __restrict__ WT,
                                               const float* __restrict__ g1, const float* __restrict__ g2, int split,
                                               LAS float* scr, int item, int lane) {
    const int nblk = N / 32, kb = item / nblk, nb = item % nblk, k0 = 64 * kb, n0 = 32 * nb;
#pragma unroll 8
    for (int i = 0; i < 32; ++i) {
        const int kk = 2 * i + (lane >> 5), k = k0 + kk;
        float w = W[(size_t)k * N + n0 + (lane & 31)];
        if (g1) w *= (k < split) ? g1[k] : g2[k - split];
        scr[kk * 33 + (lane & 31)] = w;
    }
    LDS_WAIT();
    const int c = lane & 7;
#pragma unroll
    for (int j = 0; j < 4; ++j) {
        const int n = (lane >> 3) + 8 * j;
        const LAS float* s = scr + (8 * c) * 33 + n;
        u32x4 o;
        o.x = pk2(s[0 * 33], s[1 * 33]); o.y = pk2(s[2 * 33], s[3 * 33]);
        o.z = pk2(s[4 * 33], s[5 * 33]); o.w = pk2(s[6 * 33], s[7 * 33]);
        *(u32x4*)(WT + (size_t)(n0 + n) * K + k0 + 8 * c) = o;
    }
    LDS_WAIT();
}

__device__ __forceinline__ void s5_tables(const Params& p, LAS unsigned char* lds, int g) {
    const int tid = threadIdx.x;
    LAS float* apr = (LAS float*)lds;
    LAS float* api = apr + 9 * 64;
    LAS float* bbr = api + 9 * 64;
    LAS float* bbi = bbr + 1024;
    LAS float* ccr = bbi + 1024;
    LAS float* cci = ccr + 1024;
    LAS float* kk = cci + 1024;
    const float* a_re = p.in[4]; const float* a_im = p.in[5]; const float* log_dt = p.in[6];
    const float* b_re = p.in[7]; const float* b_im = p.in[8]; const float* c_re = p.in[9]; const float* c_im = p.in[10];
    const float* dsk = p.in[11];
    float* PW = (float*)(p.ws + WS_PW) + (size_t)g * 17 * 128;
    bf16_t* TT = (bf16_t*)(p.ws + WS_TT) + (size_t)g * 128 * 256;
    bf16_t* WST = (bf16_t*)(p.ws + WS_WST) + (size_t)g * 128 * 128;
    if (tid < 64) {
        const int n = tid;
        const float lr = a_re[g * 64 + n], li = a_im[g * 64 + n], dt = expf(log_dt[g]);
        const float mag = expf(lr * dt), ang = li * dt;
        float rev = ang * 0.15915494309189535f;
        rev = rev - floorf(rev);
        const float ar = mag * __builtin_amdgcn_cosf(rev), ai = mag * __builtin_amdgcn_sinf(rev);
        float pr = 1.f, pi = 0.f;
        apr[n] = pr; api[n] = pi;
        for (int k = 1; k <= 8; ++k) {
            const float nr = pr * ar - pi * ai, ni = pr * ai + pi * ar;
            pr = nr; pi = ni; apr[k * 64 + n] = pr; api[k * 64 + n] = pi;
        }
        const float a8r = pr, a8i = pi;
        float qr = 1.f, qi = 0.f;
        for (int c = 0; c <= 16; ++c) {
            PW[c * 128 + n] = qr; PW[c * 128 + 64 + n] = qi;
            const float nr = qr * a8r - qi * a8i, ni = qr * a8i + qi * a8r;
            qr = nr; qi = ni;
        }
        const float nr = ar - 1.0f, ni = ai, den = lr * lr + li * li;
        const float cr = (nr * lr + ni * li) / den, ci = (ni * lr - nr * li) / den;
        for (int c2 = 0; c2 < 16; ++c2) {
            const float br = b_re[(size_t)(g * 64 + n) * 16 + c2], bi = b_im[(size_t)(g * 64 + n) * 16 + c2];
            bbr[n * 16 + c2] = cr * br - ci * bi;
            bbi[n * 16 + c2] = cr * bi + ci * br;
        }
    }
    for (int i = tid; i < 1024; i += NTHREADS) { ccr[i] = c_re[(size_t)g * 1024 + i]; cci[i] = c_im[(size_t)g * 1024 + i]; }
    __syncthreads();
    for (int e = tid; e < 2048; e += NTHREADS) {
        const int k = e >> 8, c = (e >> 4) & 15, c2 = e & 15;
        float s = 0.f;
        for (int n = 0; n < 64; ++n) {
            const float pr = apr[k * 64 + n], pi = api[k * 64 + n], br = bbr[n * 16 + c2], bi = bbi[n * 16 + c2];
            const float tr = pr * br - pi * bi, ti = pr * bi + pi * br;
            s += ccr[c * 64 + n] * tr - cci[c * 64 + n] * ti;
        }
        if (k == 0 && c == c2) s += dsk[g * 16 + c];
        kk[e] = s;
    }
    __syncthreads();
    for (int e = tid; e < 128 * 256; e += NTHREADS) {
        const int row = e >> 8, col = e & 255, tau = row >> 4, c = row & 15;
        float v;
        if (col < 128) {
            const int sg = col >> 4, c2 = col & 15;
            v = (tau >= sg) ? kk[((tau - sg) << 8) + (c << 4) + c2] : 0.f;
        } else {
            const int n = col & 63;
            const float pr = apr[(tau + 1) * 64 + n], pi = api[(tau + 1) * 64 + n];
            const float cr = ccr[c * 64 + n], ci = cci[c * 64 + n];
            v = (col < 192) ? (cr * pr - ci * pi) : -(cr * pi + ci * pr);
        }
        TT[e] = (bf16_t)f2bf(v);
    }
    for (int e = tid; e < 128 * 128; e += NTHREADS) {
        const int row = e >> 7, col = e & 127, part = row >> 6, n = row & 63, sg = col >> 4, c2 = col & 15;
        const float pr = apr[(7 - sg) * 64 + n], pi = api[(7 - sg) * 64 + n], br = bbr[n * 16 + c2], bi = bbi[n * 16 + c2];
        const float v = part ? (pr * bi + pi * br) : (pr * br - pi * bi);
        WST[e] = (bf16_t)f2bf(v);
    }
    __syncthreads();
}

__device__ __forceinline__ void phase0(const Params& p, LAS unsigned char* lds) {
    const int tid = threadIdx.x, lane = tid & 63, wave = tid >> 6;
    unsigned char* ws = p.ws;
    for (int g = blockIdx.x; g < NG; g += gridDim.x) s5_tables(p, lds, g);
    {
        LAS float* scr = (LAS float*)(lds + wave * 8448);
        const int gw = blockIdx.x * 8 + wave, ngw = gridDim.x * 8;
        constexpr int I0 = 16 * 48, I1 = 8 * 16, I2 = 16 * 32, I3 = 16 * 64, I4 = 16 * 32, I5 = 4 * 32;
        for (int it = gw; it < I0 + I1 + I2 + I3 + I4 + I5; it += ngw) {
            int r = it;
            if (r < I0) { transpose_item(p.in[3], 1024, 1536, (bf16_t*)(ws + WS_WIN), p.in[2], p.in[2], 1024, scr, r, lane); continue; } r -= I0;
            if (r < I1) { transpose_item(p.in[12], 512, 512, (bf16_t*)(ws + WS_WGLU), nullptr, nullptr, 0, scr, r, lane); continue; } r -= I1;
            if (r < I2) { transpose_item(p.in[20], 1024, 1024, (bf16_t*)(ws + WS_WOUT), p.in[18], p.in[19], 512, scr, r, lane); continue; } r -= I2;
            if (r < I3) { transpose_item(p.in[22], 1024, 2048, (bf16_t*)(ws + WS_WQ), p.in[21], p.in[21], 1024, scr, r, lane); continue; } r -= I3;
            if (r < I4) { transpose_item(p.in[27], 1024, 1024, (bf16_t*)(ws + WS_WGATE), p.in[26], p.in[26], 1024, scr, r, lane); continue; } r -= I4;
            transpose_item(p.in[28], 256, 1024, (bf16_t*)(ws + WS_WPROJ), nullptr, nullptr, 0, scr, r, lane);
        }
    }
    const size_t gt = (size_t)blockIdx.x * NTHREADS + tid, ngt = (size_t)gridDim.x * NTHREADS;
    {
        const float4* src = (const float4*)p.in[23]; u32x2* dst = (u32x2*)(ws + WS_KEYS);
        for (size_t i = gt; i < 65536; i += ngt) { const float4 v = src[i]; dst[i] = (u32x2){pk2(v.x, v.y), pk2(v.z, v.w)}; }
    }
    {
        const float4* src = (const float4*)p.in[16]; u32x2* dst = (u32x2*)(ws + WS_WSM);
        for (size_t i = gt; i < 16384; i += ngt) {
            float4 v = src[i];
            const int t = (int)((i >> 5) & 127), s0 = (int)(i & 31) * 4;
            if (s0 + 0 > t) v.x = 0.f; if (s0 + 1 > t) v.y = 0.f; if (s0 + 2 > t) v.z = 0.f; if (s0 + 3 > t) v.w = 0.f;
            dst[i] = (u32x2){pk2(v.x, v.y), pk2(v.z, v.w)};
        }
    }
    {
        const float4* su = (const float4*)p.in[24]; const float4* sv = (const float4*)p.in[25];
        const float4* g4 = (const float4*)p.in[21];
        unsigned* du = (unsigned*)(ws + WS_UTAB); unsigned* dv = (unsigned*)(ws + WS_VTAB);
        constexpr size_t NV4 = (size_t)16384 * 256;
        for (size_t i0 = gt; i0 < NV4; i0 += 8 * ngt) {
            float4 a[8], b[8];
#pragma unroll
            for (int k = 0; k < 8; ++k) { const size_t i = i0 + k * ngt; if (i < NV4) { a[k] = su[i]; b[k] = sv[i]; } }
            asm volatile("" ::: "memory");
#pragma unroll
            for (int k = 0; k < 8; ++k) {
                const size_t i = i0 + k * ngt;
                if (i < NV4) {
                    const float4 g = g4[i & 255];
                    int w = __builtin_amdgcn_cvt_pk_fp8_f32(a[k].x * g.x * 64.f, a[k].y * g.y * 64.f, 0, false);
                    w = __builtin_amdgcn_cvt_pk_fp8_f32(a[k].z * g.z * 64.f, a[k].w * g.w * 64.f, w, true);
                    du[i] = (unsigned)w;
                    w = __builtin_amdgcn_cvt_pk_fp8_f32(b[k].x * 4.f, b[k].y * 4.f, 0, false);
                    w = __builtin_amdgcn_cvt_pk_fp8_f32(b[k].z * 4.f, b[k].w * 4.f, w, true);
                    dv[i] = (unsigned)w;
                }
            }
        }
    }
}

__device__ __forceinline__ void phase1(const Params& p, LAS unsigned char* lds, int tile) {
    int tid = threadIdx.x;
    asm volatile("" : "+v"(tid));
    const int lane = tid & 63, wave = tid >> 6;
    unsigned char* ws = p.ws;
    const size_t tok0 = (size_t)tile * TILE;
    unsigned char* arena = ws + WS_ARENA + (size_t)tile * ARENA_BYTES;
    bf16_t* XB = (bf16_t*)(ws + WS_HB) + tok0 * 1024;
    bf16_t* XS = (bf16_t*)(arena + AR_XS);
    bf16_t* UG = (bf16_t*)(arena + AR_UG);
    bf16_t* GVT = (bf16_t*)(arena + AR_GV);
    float* HLOC = (float*)(arena + AR_HLOC);
    bf16_t* MIXA = (bf16_t*)(ws + WS_MIXA) + tok0 * 1024;
    LAS float* rs = (LAS float*)(lds + LDS_MISC);
    const float* x = p.in[0];

    rows_cvt_rstd(x + tok0 * 1024, XB, rs);
    __syncthreads();
    STAMP(20);

    const bf16_t* WIN = (const bf16_t*)(ws + WS_WIN);
    gemm_stream<256, true>(XB, 1024, 0, WIN, 1024, (size_t)256 * 1024, 1024, 4, lds, [=](int chunk, int row, int col, f32x4 v) {
        const float r = rs[row];
        const int gc = chunk * 256 + col;
        if (chunk < 2) {
            const int g = gc >> 4, c0 = gc & 15;
            *(u32x2*)(XS + ((size_t)g * 128 + row) * 16 + c0) = (u32x2){pk2(v[0] * r, v[1] * r), pk2(v[2] * r, v[3] * r)};
        } else {
            *(u32x2*)(UG + (size_t)row * 512 + (gc - 512)) = (u32x2){pk2(gelu_f(v[0] * r), gelu_f(v[1] * r)), pk2(gelu_f(v[2] * r), gelu_f(v[3] * r))};
        }
    });
    gemm_stream<256, false>(XB, 1024, 0, WIN + (size_t)1024 * 1024, 1024, (size_t)256 * 1024, 1024, 2, lds, [=](int chunk, int row, int col, f32x4 v) {
        const int gc = chunk * 256 + col;
        *(u32x2*)(GVT + (size_t)gc * 128 + row) = (u32x2){pk2(gelu_f(v[0] * rs[row]), gelu_f(v[1] * rs[row + 1])),
                                                          pk2(gelu_f(v[2] * rs[row + 2]), gelu_f(v[3] * rs[row + 3]))};
    });
    __syncthreads();
    STAMP(21);
#ifdef PROBE_DIAG
    gemm_stream<256, true, PROBE_DIAG>(XB, 1024, 0, WIN, 1024, (size_t)256 * 1024, 1024, 6, lds, [=](int chunk, int row, int col, f32x4 v) {
        if (v[0] == 123.456f) *(u32x2*)(UG + (size_t)row * 512 + (col & 255)) = (u32x2){pk2(v[0], v[1]), pk2(v[2], v[3])};
    });
    __syncthreads();
    STAMP(30);
#endif

    LAS float* stat = (LAS float*)lds;
    {
        const int s = tid & 127, head = tid >> 7;
        float sum = 0.f, sq = 0.f;
        for (int d = 0; d < 128; ++d) { const float v = bf2f(GVT[(size_t)(head * 128 + d) * 128 + s]); sum += v; sq += v * v; }
        const float mu = sum * (1.0f / 128.0f), var = sq * (1.0f / 128.0f) - mu * mu;
        stat[(head * 128 + s) * 2] = mu; stat[(head * 128 + s) * 2 + 1] = rsqrtf(fmaxf(var, 0.f) + EPS);
    }
    __syncthreads();
    {
        const float* lng = p.in[14]; const float* lnb = p.in[15];
        for (int c = tid; c < 8192; c += NTHREADS) {
            const int hd = c >> 4, s0 = (c & 15) * 8, head = hd >> 7;
            u32x4 w = *(u32x4*)(GVT + (size_t)hd * 128 + s0);
            const float g = lng[hd], b = lnb[hd];
            float o[8];
            const unsigned ww[4] = {w.x, w.y, w.z, w.w};
#pragma unroll
            for (int i = 0; i < 4; ++i) {
                const float mu0 = stat[(head * 128 + s0 + 2 * i) * 2], r0 = stat[(head * 128 + s0 + 2 * i) * 2 + 1];
                const float mu1 = stat[(head * 128 + s0 + 2 * i + 1) * 2], r1 = stat[(head * 128 + s0 + 2 * i + 1) * 2 + 1];
                o[2 * i] = (bflo(ww[i]) - mu0) * r0 * g + b;
                o[2 * i + 1] = (bfhi(ww[i]) - mu1) * r1 * g + b;
            }
            *(u32x4*)(GVT + (size_t)hd * 128 + s0) = (u32x4){pk2(o[0], o[1]), pk2(o[2], o[3]), pk2(o[4], o[5]), pk2(o[6], o[7])};
        }
    }
    __syncthreads();
    STAMP(22);

    {
        const bf16_t* WSM = (const bf16_t*)(ws + WS_WSM);
        const float* bs = p.in[17];
        gemm_stream<128, true>(WSM, 128, 16384, GVT, 128, 16384, 128, 4, lds, [=](int head, int row, int col, f32x4 v) {
            const float b = bs[head * 128 + row];
            const u32x2 uu = *(const u32x2*)(UG + (size_t)row * 512 + head * 128 + col);
            const float y0 = bflo(uu.x) * (v[0] + b), y1 = bfhi(uu.x) * (v[1] + b), y2 = bflo(uu.y) * (v[2] + b), y3 = bfhi(uu.y) * (v[3] + b);
            *(u32x2*)(MIXA + (size_t)row * 1024 + 512 + head * 128 + col) = (u32x2){pk2(y0, y1), pk2(y2, y3)};
        });
    }
    __syncthreads();
    STAMP(23);
    rows_rms512_inplace(MIXA + 512);
    STAMP(24);
    __syncthreads();
}

__device__ __forceinline__ void phaseS(const Params& p, LAS unsigned char* lds, int item) {
    int tid = threadIdx.x;
    asm volatile("" : "+v"(tid));
    const int lane = tid & 63, wave = tid >> 6, fr = lane & 15, fq = lane >> 4;
    unsigned char* ws = p.ws;
    const int g = item >> 3, pi = item & 7;
    const bf16_t* TTg = (const bf16_t*)(ws + WS_TT) + (size_t)g * 32768;
    const bf16_t* WSTg = (const bf16_t*)(ws + WS_WST) + (size_t)g * 16384;
    const float* PWg = (const float*)(ws + WS_PW) + (size_t)g * 17 * 128;
    LAS unsigned char* ltt = lds;
    LAS unsigned char* lsl = lds + 65536 + wave * 8192;
    LAS float* lst = (LAS float*)(lds + 131072);
#pragma unroll
    for (int i = 0; i < 8; ++i) {
        const int cid = tid + 512 * i, n = cid >> 5, c = cid & 31;
        const u32x4 v = *(const u32x4*)(TTg + (size_t)n * 256 + c * 8);
        *(LAS u32x4*)(ltt + n * 512 + ((c ^ (n & 15)) << 4)) = v;
    }
    const float a8r = PWg[128 + lane], a8i = PWg[128 + 64 + lane];
    const float a128r = PWg[16 * 128 + lane], a128i = PWg[16 * 128 + 64 + lane];
    float cr = 0.f, ci = 0.f;
    for (int r = 0; r < 4; ++r) {
        if ((r & 1) == 0) { cr = 0.f; ci = 0.f; }
        const int tile = ((2 * pi + (r >> 1)) << 4) + ((r & 1) << 3) + wave;
        unsigned char* arena = ws + WS_ARENA + (size_t)tile * ARENA_BYTES;
        const bf16_t* XS = (const bf16_t*)(arena + AR_XS) + (size_t)g * 2048;
        bf16_t* YS = (bf16_t*)(arena + AR_GV);
        const bf16_t* abase = XS + fr * 128 + fq * 8;
        f32x4 acc[8];
#pragma unroll
        for (int j = 0; j < 8; ++j) acc[j] = (f32x4){0.f, 0.f, 0.f, 0.f};
        bf16x8 afx[4];
#pragma unroll
        for (int ks = 0; ks < 4; ++ks) afx[ks] = *(const bf16x8*)(abase + ks * 32);
        {
            const bf16_t* bbase = WSTg + (size_t)fr * 128 + fq * 8;
#pragma unroll
            for (int ks = 0; ks < 4; ++ks)
#pragma unroll
                for (int j = 0; j < 8; ++j) {
                    const bf16x8 bfr = *(const bf16x8*)(bbase + (size_t)j * 16 * 128 + ks * 32);
                    acc[j] = __builtin_amdgcn_mfma_f32_16x16x32_bf16(bfr, afx[ks], acc[j], 0, 0, 0);
                }
        }
        __syncthreads();
#pragma unroll
        for (int j = 0; j < 8; ++j) *(LAS f32x4*)(lsl + fr * 512 + (16 * j + 4 * fq) * 4) = acc[j];
        LDS_WAIT();
        float sr[16], si[16], hlr[16], hli[16];
#pragma unroll
        for (int c = 0; c < 16; ++c) { sr[c] = *(LAS float*)(lsl + c * 512 + lane * 4); si[c] = *(LAS float*)(lsl + c * 512 + 256 + lane * 4); }
        float hr = 0.f, hi = 0.f;
#pragma unroll
        for (int c = 0; c < 16; ++c) {
            hlr[c] = hr; hli[c] = hi;
            const float nr = a8r * hr - a8i * hi + sr[c], ni = a8r * hi + a8i * hr + si[c];
            hr = nr; hi = ni;
        }
        lst[wave * 128 + lane] = hr; lst[wave * 128 + 64 + lane] = hi;
        __syncthreads();
        float Hr = cr, Hi = ci, Sr = 0.f, Si = 0.f;
#pragma unroll
        for (int w = 0; w < 8; ++w) {
            if (w == wave) { Sr = Hr; Si = Hi; }
            const float tr = lst[w * 128 + lane], ti = lst[w * 128 + 64 + lane];
            const float nr = a128r * Hr - a128i * Hi + tr, ni = a128r * Hi + a128i * Hr + ti;
            Hr = nr; Hi = ni;
        }
        cr = Hr; ci = Hi;
        {
            float pr = 1.f, pq = 0.f;
#pragma unroll
            for (int c = 0; c < 16; ++c) {
                const float vr = pr * Sr - pq * Si + hlr[c], vi = pr * Si + pq * Sr + hli[c];
                *(LAS bf16_t*)(lsl + c * 512 + ((((lane >> 3)) ^ c) << 4) + (lane & 7) * 2) = (bf16_t)f2bf(vr);
                *(LAS bf16_t*)(lsl + c * 512 + ((((64 + lane) >> 3) ^ c) << 4) + (lane & 7) * 2) = (bf16_t)f2bf(vi);
                const float nr = pr * a8r - pq * a8i, nq = pr * a8i + pq * a8r;
                pr = nr; pq = nq;
            }
        }
        LDS_WAIT();
#pragma unroll
        for (int j = 0; j < 8; ++j) acc[j] = (f32x4){0.f, 0.f, 0.f, 0.f};
#pragma unroll
        for (int ks = 0; ks < 8; ++ks) {
            bf16x8 af;
            if (ks < 4) af = afx[ks];
            else af = *(LAS bf16x8*)(lsl + fr * 512 + (((((ks - 4) * 4 + fq)) ^ fr) << 4));
#pragma unroll
            for (int j = 0; j < 8; ++j) {
                const int n = j * 16 + fr;
                const bf16x8 bfr = *(LAS bf16x8*)(ltt + n * 512 + (((ks * 4 + fq) ^ fr) << 4));
                acc[j] = __builtin_amdgcn_mfma_f32_16x16x32_bf16(bfr, af, acc[j], 0, 0, 0);
            }
        }
#pragma unroll
        for (int j = 0; j < 8; ++j) {
            const f32x4 v = acc[j];
            *(u32x2*)(YS + (size_t)(fr * 8 + j) * 512 + g * 16 + 4 * fq) = (u32x2){pk2(gelu_f(v[0]), gelu_f(v[1])), pk2(gelu_f(v[2]), gelu_f(v[3]))};
        }
    }
    __syncthreads();
}

__device__ __forceinline__ void final_rows(const Params& p, size_t tok0) {
    int tid_ = threadIdx.x;
    asm volatile("" : "+v"(tid_));
    const int lane = tid_ & 63, wave = tid_ >> 6;
    const float4* g4 = (const float4*)p.in[29];
    float4 g[4];
#pragma unroll
    for (int j = 0; j < 4; ++j) g[j] = g4[lane + 64 * j];
    for (int rb = 0; rb < 16; rb += 4) {
        float4 v[4][4];
#pragma unroll
        for (int i = 0; i < 4; ++i) {
            const float4* hr = (const float4*)(p.out + (tok0 + wave * 16 + rb + i) * 1024);
#pragma unroll
            for (int j = 0; j < 4; ++j) v[i][j] = hr[lane + 64 * j];
        }
        asm volatile("" ::: "memory");
#pragma unroll
        for (int i = 0; i < 4; ++i) {
            float4* hr = (float4*)(p.out + (tok0 + wave * 16 + rb + i) * 1024);
            float ss = 0.f;
#pragma unroll
            for (int j = 0; j < 4; ++j) ss += v[i][j].x * v[i][j].x + v[i][j].y * v[i][j].y + v[i][j].z * v[i][j].z + v[i][j].w * v[i][j].w;
            ss = wave_sum(ss);
            const float rr = rsqrtf(ss * (1.0f / 1024.0f) + EPS);
#pragma unroll
            for (int j = 0; j < 4; ++j)
                hr[lane + 64 * j] = make_float4(v[i][j].x * rr * g[j].x, v[i][j].y * rr * g[j].y, v[i][j].z * rr * g[j].z, v[i][j].w * rr * g[j].w);
        }
    }
}

__device__ __forceinline__ unsigned ord_key(float f) { const unsigned u = __float_as_uint(f); return (u & 0x80000000u) ? ~u : (u | 0x80000000u); }
__device__ __forceinline__ float ord_val(unsigned k) { return (k & 0x80000000u) ? __uint_as_float(k & 0x7fffffffu) : __uint_as_float(~k); }

__device__ __forceinline__ void phase2(const Params& p, LAS unsigned char* lds, int tile) {
    int tid = threadIdx.x;
    asm volatile("" : "+v"(tid));
    const int lane = tid & 63, wave = tid >> 6;
    unsigned char* ws = p.ws;
    const size_t tok0 = (size_t)tile * TILE;
    unsigned char* arena = ws + WS_ARENA + (size_t)tile * ARENA_BYTES;
    bf16_t* HB = (bf16_t*)(ws + WS_HB) + tok0 * 1024;
    bf16_t* XS = (bf16_t*)(arena + AR_XS);
    float* HLOC = (float*)(arena + AR_HLOC);
    bf16_t* HI = (bf16_t*)(arena + AR_HI);
    bf16_t* YS = (bf16_t*)(arena + AR_GV);
    bf16_t* MIXA = (bf16_t*)(ws + WS_MIXA) + tok0 * 1024;
    float* OUT = p.out + tok0 * 1024;
    const float* x = p.in[0] + tok0 * 1024;
    LAS float* rs = (LAS float*)(lds + LDS_MISC);
    LAS float* rs2 = (LAS float*)(lds + LDS_MISC + 512);
    const float* PW = (const float*)(ws + WS_PW);

    {
        const bf16_t* WGLU = (const bf16_t*)(ws + WS_WGLU);
        const float* gb = p.in[13];
        gemm_stream<256, true>(YS, 512, 0, WGLU, 512, (size_t)256 * 512, 512, 2, lds, [=](int chunk, int row, int col, f32x4 v) {
            const int gc = chunk * 256 + col;
            const u32x2 yy = *(const u32x2*)(YS + (size_t)row * 512 + gc);
            const float4 b = *(const float4*)(gb + gc);
            const float y0 = bflo(yy.x) * sigmoid_f(v[0] + b.x), y1 = bfhi(yy.x) * sigmoid_f(v[1] + b.y);
            const float y2 = bflo(yy.y) * sigmoid_f(v[2] + b.z), y3 = bfhi(yy.y) * sigmoid_f(v[3] + b.w);
            *(u32x2*)(MIXA + (size_t)row * 1024 + gc) = (u32x2){pk2(y0, y1), pk2(y2, y3)};
        });
    }
    __syncthreads();
    STAMP(28);
    rows_rms512_inplace(MIXA);
    __syncthreads();
    STAMP(29);
    {
        const bf16_t* WOUT = (const bf16_t*)(ws + WS_WOUT);
        gemm_stream<256, true>(MIXA, 1024, 0, WOUT, 1024, (size_t)256 * 1024, 1024, 4, lds, [=](int chunk, int row, int col, f32x4 v) {
            const int gc = chunk * 256 + col;
            const float4 xx = *(const float4*)(x + (size_t)row * 1024 + gc);
            *(float4*)(OUT + (size_t)row * 1024 + gc) = make_float4(xx.x + v[0], xx.y + v[1], xx.z + v[2], xx.w + v[3]);
        });
    }
    __syncthreads();
    STAMP(5);
    rows_cvt_rstd(OUT, HB, rs);
    __syncthreads();
    bf16_t* Q = (bf16_t*)(arena + AR_Q);
    {
        const bf16_t* WQ = (const bf16_t*)(ws + WS_WQ);
        gemm_stream<256, true>(HB, 1024, 0, WQ, 1024, (size_t)256 * 1024, 1024, 8, lds, [=](int chunk, int row, int col, f32x4 v) {
            const float r = rs[row];
            *(u32x2*)(Q + (size_t)row * 2048 + chunk * 256 + col) = (u32x2){pk2(v[0] * r, v[1] * r), pk2(v[2] * r, v[3] * r)};
        });
    }
    __syncthreads();
    STAMP(6);
    int* EIDX = (int*)(arena + AR_VNT);
    float* EGATE = (float*)(arena + AR_VNT + 65536);
    {
        const bf16_t* KEYS = (const bf16_t*)(ws + WS_KEYS);
        const int fr = lane & 15, fq = lane >> 4;
        const int wv = __builtin_amdgcn_readfirstlane(wave);
        LAS unsigned* lkey = (LAS unsigned*)(lds + 65536 + wv * 2048);
        const bf16_t* ksrc[4];
#pragma unroll
        for (int i = 0; i < 4; ++i) { const int row = 4 * (wv + 8 * i) + (lane >> 4); ksrc[i] = KEYS + (size_t)row * 128 + (((lane & 15) ^ (row & 15)) << 3); }
#define K_DMA(combo_, buf_) do { _Pragma("unroll") for (int i = 0; i < 4; ++i) \
        __builtin_amdgcn_global_load_lds((const __attribute__((address_space(1))) unsigned*)(ksrc[i] + (size_t)(combo_) * 16384), (LAS unsigned*)(lds + (buf_) * 32768 + (wv + 8 * i) * 1024), 16, 0, 0); } while (0)
        const bf16_t* qrow = Q + (size_t)(wv * 16 + fr) * 2048 + fq * 8;
        bf16x8 qa[4], qb[4];
        K_DMA(0, 0);
#pragma unroll
        for (int ks = 0; ks < 4; ++ks) qa[ks] = *(const bf16x8*)(qrow + ks * 32);
        unsigned S1[16];
#define CE(a_, b_) do { const unsigned hi_ = max(a_, b_), lo_ = min(a_, b_); a_ = hi_; b_ = lo_; } while (0)
#define SORT16(v_, o_) do { _Pragma("unroll") for (int p_ = 1; p_ < 16; p_ *= 2) _Pragma("unroll") for (int k_ = p_; k_ >= 1; k_ /= 2) \
        _Pragma("unroll") for (int j_ = k_ % p_; j_ <= 15 - k_; j_ += 2 * k_) _Pragma("unroll") for (int i_ = 0; i_ < k_; ++i_) \
            if (i_ + j_ + k_ <= 15 && (i_ + j_) / (2 * p_) == (i_ + j_ + k_) / (2 * p_)) CE(v_[(o_) + i_ + j_], v_[(o_) + i_ + j_ + k_]); } while (0)
#define BMERGE16(v_) do { _Pragma("unroll") for (int k_ = 8; k_ >= 1; k_ /= 2) _Pragma("unroll") for (int i_ = 0; i_ < 16; ++i_) \
        if ((i_ & k_) == 0) CE(v_[i_], v_[i_ + k_]); } while (0)
#define XMERGE16(v_, x_) do { unsigned o_[16]; _Pragma("unroll") for (int i_ = 0; i_ < 16; ++i_) o_[i_] = (unsigned)__shfl_xor((int)v_[15 - i_], x_); \
        _Pragma("unroll") for (int i_ = 0; i_ < 16; ++i_) v_[i_] = max(v_[i_], o_[i_]); BMERGE16(v_); } while (0)
        for (int head = 0; head < 8; ++head) {
#pragma unroll
            for (int kh = 0; kh < 2; ++kh) {
                const int combo = head * 2 + kh;
                asm volatile("s_waitcnt vmcnt(0)" ::: "memory");
                asm volatile("s_waitcnt lgkmcnt(0)" ::: "memory");
                __builtin_amdgcn_s_barrier();
                if (combo + 1 < 16) {
                    K_DMA(combo + 1, (combo + 1) & 1);
#pragma unroll
                    for (int ks = 0; ks < 4; ++ks) { if (kh == 0) qb[ks] = *(const bf16x8*)(qrow + (combo + 1) * 128 + ks * 32); else qa[ks] = *(const bf16x8*)(qrow + (combo + 1) * 128 + ks * 32); }
                }
                f32x4 acc[8];
#pragma unroll
                for (int j = 0; j < 8; ++j) acc[j] = (f32x4){0.f, 0.f, 0.f, 0.f};
                LAS unsigned char* kb = lds + (combo & 1) * 32768 + fr * 256;
#pragma unroll
                for (int ks = 0; ks < 4; ++ks) {
                    const bf16x8 af = (kh == 0) ? qa[ks] : qb[ks];
#pragma unroll
                    for (int j = 0; j < 8; ++j) {
                        const bf16x8 bfr = *(LAS bf16x8*)(kb + j * 16 * 256 + (((ks * 4 + fq) ^ fr) << 4));
                        acc[j] = __builtin_amdgcn_mfma_f32_16x16x32_bf16(bfr, af, acc[j], 0, 0, 0);
                    }
                }
                unsigned v[32];
#pragma unroll
                for (int j = 0; j < 8; ++j)
#pragma unroll
                    for (int r = 0; r < 4; ++r) v[4 * j + r] = (ord_key(acc[j][r]) & 0xFFFFFF80u) | (unsigned)(127 - (16 * j + 4 * fq + r));
                SORT16(v, 0);
                SORT16(v, 16);
                unsigned L[16];
#pragma unroll
                for (int i = 0; i < 16; ++i) L[i] = max(v[i], v[31 - i]);
                BMERGE16(L);
                XMERGE16(L, 16);
                XMERGE16(L, 32);
                if (kh == 0) {
#pragma unroll
                    for (int i = 0; i < 16; ++i) S1[i] = L[i];
                } else {
                    float s1[16], s2[16];
#pragma unroll
                    for (int i = 0; i < 16; ++i) { s1[i] = ord_val(S1[i] & 0xFFFFFF80u); s2[i] = ord_val(L[i] & 0xFFFFFF80u); }
                    unsigned c[16];
#pragma unroll
                    for (int i = 0; i < 16; ++i) c[i] = 0u;
                    {
                        int cnt = 0;
#pragma unroll
                        for (int a = 0; a < 16; ++a)
#pragma unroll
                            for (int b = 0; b < 16; ++b)
                                if ((a + 1) * (b + 1) <= 16) {
                                    const unsigned key = (ord_key(s1[a] + s2[b]) & 0xFFFFFF00u) | (unsigned)(255 - (a * 16 + b));
                                    if (fq == (cnt & 3)) c[cnt >> 2] = key;
                                    ++cnt;
                                }
                    }
                    SORT16(c, 0);
                    XMERGE16(c, 16);
                    XMERGE16(c, 32);
                    if (fq == 0) {
#pragma unroll
                        for (int i = 0; i < 4; ++i) {
                            *(LAS u32x4*)(lkey + fr * 32 + 4 * i) = (u32x4){S1[4 * i], S1[4 * i + 1], S1[4 * i + 2], S1[4 * i + 3]};
                            *(LAS u32x4*)(lkey + fr * 32 + 16 + 4 * i) = (u32x4){L[4 * i], L[4 * i + 1], L[4 * i + 2], L[4 * i + 3]};
                        }
                    }
                    float ev[16]; const float mx = ord_val(c[0] & 0xFFFFFF00u); float sum = 0.f;
#pragma unroll
                    for (int i = 0; i < 16; ++i) { ev[i] = __expf(ord_val(c[i] & 0xFFFFFF00u) - mx); sum += ev[i]; }
                    const float inv = 1.0f / sum;
                    LDS_WAIT();
                    int eo[4]; float go[4];
#pragma unroll
                    for (int i = 0; i < 4; ++i) {
                        const unsigned key = (fq == 0) ? c[i] : (fq == 1) ? c[4 + i] : (fq == 2) ? c[8 + i] : c[12 + i];
                        const float e = (fq == 0) ? ev[i] : (fq == 1) ? ev[4 + i] : (fq == 2) ? ev[8 + i] : ev[12 + i];
                        const int ab = 255 - (int)(key & 255u), a = ab >> 4, b = ab & 15;
                        const int i1 = 127 - (int)(lkey[fr * 32 + a] & 127u), i2 = 127 - (int)(lkey[fr * 32 + 16 + b] & 127u);
                        eo[i] = i1 * 128 + i2; go[i] = e * inv;
                    }
                    const int row = wv * 16 + fr;
#pragma unroll
                    for (int i = 0; i < 4; ++i) { const int e = head * 16 + 4 * fq + i; EIDX[(size_t)row * 128 + (e & 7) * 16 + (e >> 3)] = eo[i] << 10; }
                    *(float4*)(EGATE + (size_t)row * 128 + head * 16 + 4 * fq) = make_float4(go[0], go[1], go[2], go[3]);
                    LDS_WAIT();
                }
            }
        }
#undef K_DMA
    }
    __syncthreads();
    STAMP(8);
    if (tid < TILE) ((float*)(ws + WS_RSTD))[tok0 + tid] = rs[tid];
}

#define QUAD_GATHER16(dst, v4) do { \
        dst[0]  = __builtin_amdgcn_update_dpp(0, (int)v4.x, 0x00, 0xF, 0xF, true); dst[1]  = __builtin_amdgcn_update_dpp(0, (int)v4.y, 0x00, 0xF, 0xF, true); \
        dst[2]  = __builtin_amdgcn_update_dpp(0, (int)v4.z, 0x00, 0xF, 0xF, true); dst[3]  = __builtin_amdgcn_update_dpp(0, (int)v4.w, 0x00, 0xF, 0xF, true); \
        dst[4]  = __builtin_amdgcn_update_dpp(0, (int)v4.x, 0x55, 0xF, 0xF, true); dst[5]  = __builtin_amdgcn_update_dpp(0, (int)v4.y, 0x55, 0xF, 0xF, true); \
        dst[6]  = __builtin_amdgcn_update_dpp(0, (int)v4.z, 0x55, 0xF, 0xF, true); dst[7]  = __builtin_amdgcn_update_dpp(0, (int)v4.w, 0x55, 0xF, 0xF, true); \
        dst[8]  = __builtin_amdgcn_update_dpp(0, (int)v4.x, 0xAA, 0xF, 0xF, true); dst[9]  = __builtin_amdgcn_update_dpp(0, (int)v4.y, 0xAA, 0xF, 0xF, true); \
        dst[10] = __builtin_amdgcn_update_dpp(0, (int)v4.z, 0xAA, 0xF, 0xF, true); dst[11] = __builtin_amdgcn_update_dpp(0, (int)v4.w, 0xAA, 0xF, 0xF, true); \
        dst[12] = __builtin_amdgcn_update_dpp(0, (int)v4.x, 0xFF, 0xF, 0xF, true); dst[13] = __builtin_amdgcn_update_dpp(0, (int)v4.y, 0xFF, 0xF, 0xF, true); \
        dst[14] = __builtin_amdgcn_update_dpp(0, (int)v4.z, 0xFF, 0xF, 0xF, true); dst[15] = __builtin_amdgcn_update_dpp(0, (int)v4.w, 0xFF, 0xF, 0xF, true); } while (0)

__device__ __forceinline__ void peer_u_item(const Params& p, int tile, int j) {
    int tid = threadIdx.x;
    asm volatile("" : "+v"(tid));
    const int lane = tid & 63, wave = tid >> 6, q = lane & 7, g = lane >> 3;
    unsigned char* ws = p.ws;
    const size_t tok0 = (size_t)tile * TILE;
    unsigned char* arena = ws + WS_ARENA + (size_t)tile * ARENA_BYTES;
    const bf16_t* HB = (const bf16_t*)(ws + WS_HB) + (tok0 + wave * 16) * 1024 + j * 128 + q * 16;
    const u32x4* EIDT = (const u32x4*)((const int*)(arena + AR_VNT) + (size_t)(wave * 16) * 128 + g * 16 + 4 * (q & 3));
    float* PD = (float*)(arena + AR_Q) + ((size_t)(wave * 16) * 8 + j) * 128 + 8 * q + g;
    const __amdgpu_buffer_rsrc_t ursrc = __builtin_amdgcn_make_buffer_rsrc(ws + WS_UTAB, 0, 16384 * 1024, 0x00020000);
    u32x4 i4 = EIDT[0];
    for (int tt = 0; tt < 16; ++tt) {
        int idx[16];
        QUAD_GATHER16(idx, i4);
        const u32x4 xa = *(const u32x4*)(HB + (size_t)tt * 1024), xb = *(const u32x4*)(HB + (size_t)tt * 1024 + 8);
        u32x4 w[16];
#pragma unroll
        for (int it = 0; it < 16; ++it) w[it] = __builtin_amdgcn_raw_buffer_load_b128(ursrc, idx[it] + q * 16, j * 128, 0);
        if (tt + 1 < 16) i4 = EIDT[(size_t)(tt + 1) * 32];
        asm volatile("" ::: "memory");
        f32x2 x2[8];
        x2[0] = (f32x2){bflo(xa.x), bfhi(xa.x)}; x2[1] = (f32x2){bflo(xa.y), bfhi(xa.y)}; x2[2] = (f32x2){bflo(xa.z), bfhi(xa.z)}; x2[3] = (f32x2){bflo(xa.w), bfhi(xa.w)};
        x2[4] = (f32x2){bflo(xb.x), bfhi(xb.x)}; x2[5] = (f32x2){bflo(xb.y), bfhi(xb.y)}; x2[6] = (f32x2){bflo(xb.z), bfhi(xb.z)}; x2[7] = (f32x2){bflo(xb.w), bfhi(xb.w)};
        float r0 = 0.f, r1 = 0.f;
#pragma unroll
        for (int it = 0; it < 16; ++it) {
            f32x2 acc = {0.f, 0.f};
            acc = __builtin_amdgcn_cvt_pk_f32_fp8(w[it].x, false) * x2[0] + acc; acc = __builtin_amdgcn_cvt_pk_f32_fp8(w[it].x, true) * x2[1] + acc;
            acc = __builtin_amdgcn_cvt_pk_f32_fp8(w[it].y, false) * x2[2] + acc; acc = __builtin_amdgcn_cvt_pk_f32_fp8(w[it].y, true) * x2[3] + acc;
            acc = __builtin_amdgcn_cvt_pk_f32_fp8(w[it].z, false) * x2[4] + acc; acc = __builtin_amdgcn_cvt_pk_f32_fp8(w[it].z, true) * x2[5] + acc;
            acc = __builtin_amdgcn_cvt_pk_f32_fp8(w[it].w, false) * x2[6] + acc; acc = __builtin_amdgcn_cvt_pk_f32_fp8(w[it].w, true) * x2[7] + acc;
            float sdot = acc.x + acc.y;
            sdot += DPP_F(sdot, 0xB1); sdot += DPP_F(sdot, 0x4E); sdot += DPP_F(sdot, 0x141);
            if (q == (it & 7)) { if (it < 8) r0 = sdot; else r1 = sdot; }
        }
        float* pd = PD + (size_t)tt * 8 * 128;
        pd[0] = r0; pd[64] = r1;
    }
}

__device__ __forceinline__ void peer_act(const Params& p, int tile) {
    int tid = threadIdx.x;
    asm volatile("" : "+v"(tid));
    const int lane = tid & 63, wave = tid >> 6;
    unsigned char* ws = p.ws;
    const size_t tok0 = (size_t)tile * TILE;
    unsigned char* arena = ws + WS_ARENA + (size_t)tile * ARENA_BYTES;
    const float* EGATE = (const float*)(arena + AR_VNT + 65536);
    const float* PD = (const float*)(arena + AR_Q);
    const float* RSTD = (const float*)(ws + WS_RSTD) + tok0;
    float* ACT = (float*)(arena + AR_GV);
    const int p0 = (lane & 7) * 16 + (lane >> 3), p1 = p0 + 8;
    for (int rb = 0; rb < 16; rb += 4) {
        float pd[4][16]; float gt[4][2]; float rsd[4];
#pragma unroll
        for (int i = 0; i < 4; ++i) {
            const int row = wave * 16 + rb + i;
#pragma unroll
            for (int jj = 0; jj < 8; ++jj) { pd[i][2 * jj] = PD[((size_t)row * 8 + jj) * 128 + lane]; pd[i][2 * jj + 1] = PD[((size_t)row * 8 + jj) * 128 + 64 + lane]; }
            gt[i][0] = EGATE[(size_t)row * 128 + lane]; gt[i][1] = EGATE[(size_t)row * 128 + 64 + lane];
            rsd[i] = RSTD[row];
        }
        asm volatile("" ::: "memory");
#pragma unroll
        for (int i = 0; i < 4; ++i) {
            const int row = wave * 16 + rb + i;
            const float sc = rsd[i] * (1.0f / 64.0f);
            float s0 = 0.f, s1 = 0.f;
#pragma unroll
            for (int jj = 0; jj < 8; ++jj) { s0 += pd[i][2 * jj]; s1 += pd[i][2 * jj + 1]; }
            ACT[(size_t)row * 128 + p0] = gelu_f(s0 * sc) * gt[i][0] * 0.25f;
            ACT[(size_t)row * 128 + p1] = gelu_f(s1 * sc) * gt[i][1] * 0.25f;
        }
    }
}

__device__ __forceinline__ void peer_v_item(const Params& p, int tile, int j) {
    int tid = threadIdx.x;
    asm volatile("" : "+v"(tid));
    const int lane = tid & 63, wave = tid >> 6, q = lane & 7, g = lane >> 3;
    unsigned char* ws = p.ws;
    const size_t tok0 = (size_t)tile * TILE;
    unsigned char* arena = ws + WS_ARENA + (size_t)tile * ARENA_BYTES;
    const bool b5 = (lane & 32) != 0, b4 = (lane & 16) != 0, b3 = (lane & 8) != 0;
    const int col = j * 128 + q * 16 + (b5 ? 8 : 0) + (b4 ? 4 : 0) + (b3 ? 2 : 0);
    bf16_t* HB = (bf16_t*)(ws + WS_HB) + (tok0 + wave * 16) * 1024 + col;
    float* OUT = p.out + (tok0 + wave * 16) * 1024 + col;
    const u32x4* EIDT = (const u32x4*)((const int*)(arena + AR_VNT) + (size_t)(wave * 16) * 128 + g * 16 + 4 * (q & 3));
    const u32x4* ACTT = (const u32x4*)((const float*)(arena + AR_GV) + (size_t)(wave * 16) * 128 + g * 16 + 4 * (q & 3));
    float* SSQ = (float*)(ws + WS_SSQ) + (tok0 + wave * 16) * 8 + j;
    const __amdgpu_buffer_rsrc_t vrsrc = __builtin_amdgcn_make_buffer_rsrc(ws + WS_VTAB, 0, 16384 * 1024, 0x00020000);
    u32x4 i4, a4a, a4b;
    u32x4 w0[16], w1[16];
    float2 h0, h1;
#define PV_ENT(t_) do { i4 = EIDT[(size_t)(t_) * 32]; } while (0)
#define PV_GATHER(W, A4, H, t_) do { int idx_[16]; QUAD_GATHER16(idx_, i4); \
        _Pragma("unroll") for (int it = 0; it < 16; ++it) W[it] = __builtin_amdgcn_raw_buffer_load_b128(vrsrc, idx_[it] + q * 16, j * 128, 0); \
        A4 = ACTT[(size_t)(t_) * 32]; H = *(const float2*)(OUT + (size_t)(t_) * 1024); } while (0)
#define PV_COMPUTE(W, A4, H, t_) do { \
        int avi_[16]; QUAD_GATHER16(avi_, A4); \
        f32x2 y2[8]; \
        _Pragma("unroll") for (int i = 0; i < 8; ++i) y2[i] = (f32x2){0.f, 0.f}; \
        _Pragma("unroll") for (int it = 0; it < 16; ++it) { \
            const float a_ = __builtin_bit_cast(float, avi_[it]); const f32x2 a2 = {a_, a_}; \
            y2[0] = __builtin_amdgcn_cvt_pk_f32_fp8(W[it].x, false) * a2 + y2[0]; y2[1] = __builtin_amdgcn_cvt_pk_f32_fp8(W[it].x, true) * a2 + y2[1]; \
            y2[2] = __builtin_amdgcn_cvt_pk_f32_fp8(W[it].y, false) * a2 + y2[2]; y2[3] = __builtin_amdgcn_cvt_pk_f32_fp8(W[it].y, true) * a2 + y2[3]; \
            y2[4] = __builtin_amdgcn_cvt_pk_f32_fp8(W[it].z, false) * a2 + y2[4]; y2[5] = __builtin_amdgcn_cvt_pk_f32_fp8(W[it].z, true) * a2 + y2[5]; \
            y2[6] = __builtin_amdgcn_cvt_pk_f32_fp8(W[it].w, false) * a2 + y2[6]; y2[7] = __builtin_amdgcn_cvt_pk_f32_fp8(W[it].w, true) * a2 + y2[7]; \
        } \
          \
        f32x2 k4[4]; \
        _Pragma("unroll") for (int i = 0; i < 4; ++i) { \
            const auto rx = __builtin_amdgcn_permlane32_swap(__float_as_uint(y2[i].x), __float_as_uint(y2[4 + i].x), false, false); \
            const auto ry = __builtin_amdgcn_permlane32_swap(__float_as_uint(y2[i].y), __float_as_uint(y2[4 + i].y), false, false); \
            k4[i] = (f32x2){__uint_as_float(rx[0]) + __uint_as_float(rx[1]), __uint_as_float(ry[0]) + __uint_as_float(ry[1])}; \
        } \
        f32x2 k2[2]; \
        _Pragma("unroll") for (int i = 0; i < 2; ++i) { \
            const auto rx = __builtin_amdgcn_permlane16_swap(__float_as_uint(k4[i].x), __float_as_uint(k4[2 + i].x), false, false); \
            const auto ry = __builtin_amdgcn_permlane16_swap(__float_as_uint(k4[i].y), __float_as_uint(k4[2 + i].y), false, false); \
            k2[i] = (f32x2){__uint_as_float(rx[0]) + __uint_as_float(rx[1]), __uint_as_float(ry[0]) + __uint_as_float(ry[1])}; \
        } \
        const f32x2 keep = b3 ? k2[1] : k2[0], send = b3 ? k2[0] : k2[1]; \
        const float h20 = H.x + keep.x + __shfl_xor(send.x, 8), h21 = H.y + keep.y + __shfl_xor(send.y, 8); \
        *(float2*)(OUT + (size_t)(t_) * 1024) = make_float2(h20, h21); \
        *(unsigned*)(HB + (size_t)(t_) * 1024) = pk2(h20, h21); \
        const float ss = wave_sum(h20 * h20 + h21 * h21); \
        if (lane == 0) SSQ[(t_) * 8] = ss; } while (0)
    PV_ENT(0);
    PV_GATHER(w0, a4a, h0, 0);
    asm volatile("" ::: "memory");
    PV_ENT(1);
    asm volatile("" ::: "memory");
    for (int tt = 0; tt < 16; tt += 2) {
        PV_GATHER(w1, a4b, h1, tt + 1);
        asm volatile("" ::: "memory");
        if (tt + 2 < 16) PV_ENT(tt + 2);
        asm volatile("" ::: "memory");
        PV_COMPUTE(w0, a4a, h0, tt);
        if (tt + 2 < 16) {
            PV_GATHER(w0, a4a, h0, tt + 2);
            asm volatile("" ::: "memory");
            PV_ENT(tt + 3);
        }
        asm volatile("" ::: "memory");
        PV_COMPUTE(w1, a4b, h1, tt + 1);
    }
#undef PV_ENT
#undef PV_GATHER
#undef PV_COMPUTE
}

__device__ __forceinline__ void phase5(const Params& p, LAS unsigned char* lds, int tile) {
    int tid = threadIdx.x;
    asm volatile("" : "+v"(tid));
    const int lane = tid & 63, wave = tid >> 6;
    unsigned char* ws = p.ws;
    const size_t tok0 = (size_t)tile * TILE;
    unsigned char* arena = ws + WS_ARENA + (size_t)tile * ARENA_BYTES;
    bf16_t* HB = (bf16_t*)(ws + WS_HB) + tok0 * 1024;
    float* OUT = p.out + tok0 * 1024;
    LAS float* rs2 = (LAS float*)(lds + LDS_MISC + 512);
    if (tid < TILE) {
        const float* sq = (const float*)(ws + WS_SSQ) + (tok0 + tid) * 8;
        float ss = 0.f;
#pragma unroll
        for (int jj = 0; jj < 8; ++jj) ss += sq[jj];
        rs2[tid] = rsqrtf(ss * (1.0f / 1024.0f) + EPS);
    }
    bf16_t* PB = (bf16_t*)(arena + AR_HI);
    {
        const float* pp = p.in[1] + tok0 * 256;
        for (int r = wave; r < TILE; r += 8) {
            const float4 v = *(const float4*)(pp + (size_t)r * 256 + lane * 4);
            *(u32x2*)(PB + (size_t)r * 256 + lane * 4) = (u32x2){pk2(v.x, v.y), pk2(v.z, v.w)};
        }
    }
    __syncthreads();
    bf16_t* PP = (bf16_t*)(arena + AR_PP);
    {
        const bf16_t* WPROJ = (const bf16_t*)(ws + WS_WPROJ);
        gemm_stream<256, true>(PB, 256, 0, WPROJ, 256, (size_t)256 * 256, 256, 4, lds, [=](int chunk, int row, int col, f32x4 v) {
            *(u32x2*)(PP + (size_t)row * 1024 + chunk * 256 + col) = (u32x2){pk2(v[0], v[1]), pk2(v[2], v[3])};
        });
    }
    __syncthreads();
    {
        const bf16_t* WGATE = (const bf16_t*)(ws + WS_WGATE);
        gemm_stream<256, true>(HB, 1024, 0, WGATE, 1024, (size_t)256 * 1024, 1024, 4, lds, [=](int chunk, int row, int col, f32x4 v) {
            const float r = rs2[row];
            const int gc = chunk * 256 + col;
            const u32x2 pv = *(const u32x2*)(PP + (size_t)row * 1024 + gc);
            float4 h = *(const float4*)(OUT + (size_t)row * 1024 + gc);
            h.x += sigmoid_f(v[0] * r) * bflo(pv.x); h.y += sigmoid_f(v[1] * r) * bfhi(pv.x);
            h.z += sigmoid_f(v[2] * r) * bflo(pv.y); h.w += sigmoid_f(v[3] * r) * bfhi(pv.y);
            *(float4*)(OUT + (size_t)row * 1024 + gc) = h;
        });
    }
    __syncthreads();
    STAMP(10);
    final_rows(p, tok0);
    __syncthreads();
    STAMP(11);
}

#define XB_TMO      128
#define XB_XCNT(j)  (256  + 64 * (j))
#define XB_XSUB(j)  (1280 + 64 * (j))
#define XB_XGEN(j)  (2304 + 64 * (j))
#define XB_TOP      3328
#define XB_TOPGEN   3392
#define XCD_BAR_WORDS 3456
#define XB_SPIN_CAP (1u << 22)
__device__ __forceinline__ unsigned xb_ld(unsigned* p)              { return __hip_atomic_load(p, __ATOMIC_RELAXED, __HIP_MEMORY_SCOPE_AGENT); }
__device__ __forceinline__ unsigned xb_add(unsigned* p, unsigned v) { return __hip_atomic_fetch_add(p, v, __ATOMIC_RELAXED, __HIP_MEMORY_SCOPE_AGENT); }
__device__ __forceinline__ unsigned xb_xcc_id() { return (unsigned)__builtin_amdgcn_s_getreg((3 << 11) | 20) & 0xFu; }
#define XB_SPIN(cond, bar) do { unsigned _sp = 0; while (cond) { __builtin_amdgcn_s_sleep(1); \
    if ((++_sp & 255u) == 0u) { if (xb_ld(&(bar)[XB_TMO])) break; if (_sp > XB_SPIN_CAP) { atomicAdd(&(bar)[XB_TMO], 1u); break; } } } } while (0)
struct XcdBarrier { unsigned* bar; unsigned x; volatile LAS unsigned* st; };
__device__ __forceinline__ XcdBarrier xcd_barrier_post(unsigned* bar, volatile LAS unsigned* st) {
    XcdBarrier b; b.bar = bar; b.x = xb_xcc_id(); b.st = st;
    if (threadIdx.x == 0) (void)xb_add(&bar[XB_XCNT(b.x)], 1u);
    return b;
}
__device__ __forceinline__ void xcd_barrier_complete(unsigned* bar, unsigned x, unsigned& nloc, unsigned& nx) {
    const unsigned G = gridDim.x * gridDim.y * gridDim.z;
    unsigned sum, cnt, mine, sp = 0u;
    for (;;) {
        sum = 0u; cnt = 0u; mine = 0u;
#pragma unroll
        for (unsigned j = 0; j < 16; ++j) { const unsigned c = xb_ld(&bar[XB_XCNT(j)]); sum += c; cnt += (c > 0u) ? 1u : 0u; mine = (j == x) ? c : mine; }
        if (sum == G) break;
        __builtin_amdgcn_s_sleep(1);
        if ((++sp & 255u) == 0u) { if (xb_ld(&bar[XB_TMO])) break; if (sp > XB_SPIN_CAP) { atomicAdd(&bar[XB_TMO], 1u); break; } }
    }
    nloc = mine > 0u ? mine : 1u; nx = cnt > 0u ? cnt : 1u;
}
__device__ __forceinline__ void xcd_barrier(const XcdBarrier& b) {
    asm volatile("s_waitcnt vmcnt(0)" ::: "memory");
    __syncthreads();
    if (threadIdx.x == 0) {
        unsigned* bar = b.bar;
        __builtin_amdgcn_s_waitcnt(0);
        unsigned nloc = b.st[0], nx = b.st[1];
        if (nloc == 0u) { xcd_barrier_complete(bar, b.x, nloc, nx); b.st[0] = nloc; b.st[1] = nx; }
        const unsigned old = xb_add(&bar[XB_XSUB(b.x)], 1u);
        const unsigned gen = old / nloc;
        if (old + 1u == (gen + 1u) * nloc) {
            __builtin_amdgcn_fence(__ATOMIC_RELEASE, "agent");
            asm volatile("s_waitcnt vmcnt(0)" ::: "memory");
            const unsigned og = xb_add(&bar[XB_TOP], 1u);
            const unsigned tg = og / nx;
            if (og + 1u == (tg + 1u) * nx) xb_add(&bar[XB_TOPGEN], 1u);
            else XB_SPIN(xb_ld(&bar[XB_TOPGEN]) == tg, bar);
            __builtin_amdgcn_fence(__ATOMIC_ACQUIRE, "agent");
            xb_add(&bar[XB_XGEN(b.x)], 1u);
            asm volatile("s_waitcnt vmcnt(0)" ::: "memory");
        } else {
            XB_SPIN(xb_ld(&bar[XB_XGEN(b.x)]) == gen, bar);
            __builtin_amdgcn_fence(__ATOMIC_ACQUIRE, "agent");
            asm volatile("s_waitcnt vmcnt(0)" ::: "memory");
        }
    }
    __syncthreads();
}

__global__ void __launch_bounds__(NTHREADS) fwd_kernel(Params p) {
    __shared__ __attribute__((aligned(16))) unsigned char lds_raw[LDS_BYTES];
    LAS unsigned char* lds = (LAS unsigned char*)lds_raw;
    cg::grid_group grid = cg::this_grid();
    volatile LAS unsigned* bst = (volatile LAS unsigned*)(lds + LDS_MISC + 1024);
    if (threadIdx.x == 0) { bst[0] = 0u; bst[1] = 0u; }
    __syncthreads();
    XcdBarrier bar = xcd_barrier_post((unsigned*)(p.ws + WS_BAR), bst);
    STAMP(0);
#ifdef PROBE_A
    if (blockIdx.x == 0 && threadIdx.x == 0) *(unsigned*)(p.ws + WS_END) = 0u;
#endif
    phase0(p, lds);
    STAMP(1);
    grid.sync();
    STAMP(2);
    for (int tile = blockIdx.x; tile < NTILES; tile += gridDim.x) phase1(p, lds, tile);
    STAMP(3);
    xcd_barrier(bar);
    STAMP(4);
    for (int it = blockIdx.x; it < NG * 8; it += gridDim.x) phaseS(p, lds, it);
    STAMP(18);
    xcd_barrier(bar);
    STAMP(19);
    for (int tile = blockIdx.x; tile < NTILES; tile += gridDim.x) phase2(p, lds, tile);
    STAMP(12);
    xcd_barrier(bar);
    STAMP(13);
    for (int it = blockIdx.x; it < NTILES * 8; it += gridDim.x) peer_u_item(p, it >> 3, it & 7);
    STAMP(14);
    xcd_barrier(bar);
    for (int tile = blockIdx.x; tile < NTILES; tile += gridDim.x) peer_act(p, tile);
    xcd_barrier(bar);
    STAMP(15);
    for (int it = blockIdx.x; it < NTILES * 8; it += gridDim.x) peer_v_item(p, it >> 3, it & 7);
    STAMP(16);
    xcd_barrier(bar);
    STAMP(17);
    for (int tile = blockIdx.x; tile < NTILES; tile += gridDim.x) phase5(p, lds, tile);
#ifdef PROBE_A
    {
        LAS unsigned long long* ts = (LAS unsigned long long*)(lds + LDS_MISC + 2048);
        unsigned* mx = (unsigned*)(p.ws + WS_END);
        if (threadIdx.x == 0) atomicMax(mx, (unsigned)(ts[PROBE_B] - ts[PROBE_A]));
        grid.sync();
        if (blockIdx.x == 0 && threadIdx.x == 0) {
            const unsigned long long dly = (unsigned long long)__hip_atomic_load(mx, __ATOMIC_RELAXED, __HIP_MEMORY_SCOPE_AGENT) * PROBE_MUL, t_end = __builtin_amdgcn_s_memrealtime();
            while (__builtin_amdgcn_s_memrealtime() - t_end < dly) __builtin_amdgcn_s_sleep(8);
        }
    }
#endif
}

extern "C" void kernel_launch(void* const* d_in, const int* in_sizes, int n_in, void* d_out, int out_size, void* d_ws, size_t ws_size,
                              hipStream_t stream) {
    static int grid_blocks = 0;
    if (!grid_blocks) {
        int dev = 0, cus = 0, per_cu = 0;
        (void)hipGetDevice(&dev);
        (void)hipDeviceGetAttribute(&cus, hipDeviceAttributeMultiprocessorCount, dev);
        (void)hipOccupancyMaxActiveBlocksPerMultiprocessor(&per_cu, fwd_kernel, NTHREADS, 0);
        if (per_cu < 1) { fprintf(stderr, "kernel_launch: occupancy query says %d blocks per CU\n", per_cu); per_cu = 1; }
        grid_blocks = cus * 1;
        if (grid_blocks > NTILES) grid_blocks = NTILES;
        if (ws_size < WS_END) fprintf(stderr, "kernel_launch: workspace too small: %zu < %zu\n", ws_size, (size_t)WS_END);
        fprintf(stderr, "kernel_launch: cus=%d per_cu=%d grid=%d ws=%zu need=%zu\n", cus, per_cu, grid_blocks, ws_size, (size_t)WS_END);
    }
    (void)hipMemsetAsync((unsigned char*)d_ws + WS_BAR, 0, 16384, stream);
    Params p{};
    for (int i = 0; i < 30; ++i) p.in[i] = (const float*)d_in[i];
    p.out = (float*)d_out;
    p.ws = (unsigned char*)d_ws;
    void* args[] = {&p};
    hipError_t e = hipLaunchCooperativeKernel((void*)fwd_kernel, dim3(grid_blocks), dim3(NTHREADS), args, 0, stream);
    if (e != hipSuccess) fprintf(stderr, "cooperative launch failed: %s (grid %d)\n", hipGetErrorString(e), grid_blocks);
}
```

```cpp
#include <hip/hip_runtime.h>
#include <hip/hip_cooperative_groups.h>
#include <cstdio>
#include <cstdint>
namespace cg = cooperative_groups;


#define LAS __attribute__((address_space(3)))
typedef unsigned short bf16_t;
typedef short bf16x8 __attribute__((ext_vector_type(8)));
typedef float f32x4 __attribute__((ext_vector_type(4)));
typedef float f32x2 __attribute__((ext_vector_type(2)));
typedef unsigned u32x4 __attribute__((ext_vector_type(4)));
typedef unsigned u32x2 __attribute__((ext_vector_type(2)));

constexpr int T_TOK = 16 * 2048, SEQ = 2048, D = 1024, DIN = 1536;
constexpr int NG = 32;
constexpr int TILE = 128, NTILES = T_TOK / TILE, TPS = SEQ / TILE;
constexpr float EPS = 1e-6f;
constexpr int NTHREADS = 512;

constexpr size_t WS_WIN = 0;
constexpr size_t WS_WGLU = WS_WIN + (size_t)1536 * 1024 * 2;
constexpr size_t WS_WOUT = WS_WGLU + (size_t)512 * 512 * 2;
constexpr size_t WS_WQ = WS_WOUT + (size_t)1024 * 1024 * 2;
constexpr size_t WS_KEYS = WS_WQ + (size_t)2048 * 1024 * 2;
constexpr size_t WS_WGATE = WS_KEYS + (size_t)16 * 128 * 128 * 2;
constexpr size_t WS_WPROJ = WS_WGATE + (size_t)1024 * 1024 * 2;
constexpr size_t WS_WSM = WS_WPROJ + (size_t)1024 * 256 * 2;
constexpr size_t WS_TT = WS_WSM + (size_t)4 * 128 * 128 * 2;
constexpr size_t WS_WST = WS_TT + (size_t)32 * 128 * 256 * 2;
constexpr size_t WS_PW = WS_WST + (size_t)32 * 128 * 128 * 2;
constexpr size_t WS_STILE = WS_PW + (size_t)32 * 17 * 128 * 4;
constexpr size_t WS_UTAB = WS_STILE + (size_t)256 * 32 * 128 * 4;
constexpr size_t WS_VTAB = WS_UTAB + (size_t)16384 * 1024;
constexpr size_t WS_RSTD = WS_VTAB + (size_t)16384 * 1024;
constexpr size_t WS_SSQ = WS_RSTD + (size_t)T_TOK * 4;
constexpr size_t WS_BAR = WS_SSQ + (size_t)T_TOK * 8 * 4;
constexpr size_t WS_MIXA = WS_BAR + 16384;
constexpr size_t WS_HB = WS_MIXA + (size_t)T_TOK * 1024 * 2;
constexpr size_t WS_ARENA = WS_HB + (size_t)T_TOK * 1024 * 2;
constexpr size_t AR_XS = 0;
constexpr size_t AR_HLOC = 131072;
constexpr size_t AR_UG = 393216;
constexpr size_t AR_Q = 0;
constexpr size_t AR_PP = 0;
constexpr size_t AR_GV = 524288;
constexpr size_t AR_VNT = 655360;
constexpr size_t AR_HI = 786432;
constexpr size_t ARENA_BYTES = 917504;
constexpr size_t WS_END = WS_ARENA + (size_t)NTILES * ARENA_BYTES;

constexpr int LDS_MISC = 147456;
constexpr int LDS_BYTES = LDS_MISC + 4096;

struct Params {
    const float* in[30];
    float* out;
    unsigned char* ws;
};

typedef __bf16 bf16v2 __attribute__((ext_vector_type(2)));
__device__ __forceinline__ unsigned pk2(float lo, float hi) {
    const f32x2 v = {lo, hi};
    return __builtin_bit_cast(unsigned, __builtin_convertvector(v, bf16v2));
}
__device__ __forceinline__ unsigned f2bf(float f) { return pk2(f, 0.f) & 0xffffu; }
__device__ __forceinline__ float bflo(unsigned w) { return __uint_as_float(w << 16); }
__device__ __forceinline__ float bfhi(unsigned w) { return __uint_as_float(w & 0xffff0000u); }
__device__ __forceinline__ float bf2f(bf16_t b) { return __uint_as_float((unsigned)b << 16); }
#define DPP_F(v, ctrl) __builtin_bit_cast(float, __builtin_amdgcn_update_dpp(0, __builtin_bit_cast(int, (v)), (ctrl), 0xF, 0xF, true))
__device__ __forceinline__ float wave_sum(float v) {
#pragma unroll
    for (int o = 1; o < 64; o <<= 1) v += __shfl_xor(v, o);
    return v;
}
__device__ __forceinline__ float gelu_f(float v) {
    const float av = fabsf(v);
    const float t = __builtin_amdgcn_rcpf(av * 0.2316418882f + 1.0f);
    float q = t * 0.5307027145f + (-0.7265760135f);
    q = q * t + 0.7107068705f; q = q * t + (-0.142248368f); q = q * t + 0.127414796f; q = q * t;
    const float e = __builtin_amdgcn_exp2f(v * v * (-0.72134752044f));
    const float m = v * (q * e);
    return v < 0.f ? m : v - m;
}
__device__ __forceinline__ f32x2 gelu2(f32x2 v) {
    const f32x2 av = __builtin_elementwise_abs(v), d = av * 0.2316418882f + 1.0f;
    f32x2 t; t.x = __builtin_amdgcn_rcpf(d.x); t.y = __builtin_amdgcn_rcpf(d.y);
    f32x2 q = t * 0.5307027145f + (-0.7265760135f);
    q = q * t + 0.7107068705f; q = q * t + (-0.142248368f); q = q * t + 0.127414796f; q = q * t;
    const f32x2 s = (v * v) * (-0.72134752044f);
    f32x2 e; e.x = __builtin_amdgcn_exp2f(s.x); e.y = __builtin_amdgcn_exp2f(s.y);
    const f32x2 m = v * (q * e), r = v - m;
    f32x2 o; o.x = v.x < 0.f ? m.x : r.x; o.y = v.y < 0.f ? m.y : r.y;
    return o;
}
__device__ __forceinline__ unsigned gelu_pk2(float a, float b) { const f32x2 g = gelu2((f32x2){a, b}); return pk2(g.x, g.y); }
__device__ __forceinline__ float sigmoid_f(float x) {
    return __builtin_amdgcn_rcpf(1.0f + __builtin_amdgcn_exp2f(x * (-1.44269504089f)));
}
#define LDS_WAIT() asm volatile("s_waitcnt lgkmcnt(0)" ::: "memory")
#ifdef PROBE_A
#define STAMP(i) do { if (threadIdx.x == 0) ((LAS unsigned long long*)(lds + LDS_MISC + 2048))[i] = __builtin_amdgcn_s_memrealtime(); } while (0)
#else
#define STAMP(i) do { } while (0)
#endif

template <int BN, bool TR, int DIAG = 0, class Epi>
__device__ __forceinline__ void gemm_tile(const bf16_t* __restrict__ A, int lda, const bf16_t* __restrict__ Bt, int ldb, int K,
                                          LAS unsigned char* lds, const Epi& epi) {
    constexpr int NT = BN / 64;
    constexpr int NPB = BN / 64;
    constexpr int NP = 2 + NPB;
    constexpr int A_BYTES = 128 * 128;
    constexpr int B_BYTES = BN * 128;
    constexpr int STAGE = A_BYTES + B_BYTES;
    constexpr int A_AUX = 0;
    int tid = threadIdx.x;
    asm volatile("" : "+v"(tid));
    const int lane = tid & 63, wave = __builtin_amdgcn_readfirstlane(tid >> 6), wm = wave >> 2, wn = wave & 3;
    f32x4 acc[4][NT];
#pragma unroll
    for (int i = 0; i < 4; ++i)
#pragma unroll
        for (int j = 0; j < NT; ++j) acc[i][j] = (f32x4){0.f, 0.f, 0.f, 0.f};
    const int prow = lane >> 3;
    const bf16_t* asrc[2]; const bf16_t* bsrc[NPB];
#pragma unroll
    for (int i = 0; i < 2; ++i) { const int row = 8 * (wave + 8 * i) + prow; asrc[i] = A + (size_t)row * lda + (((lane & 7) ^ ((row >> 1) & 7)) << 3); }
#pragma unroll
    for (int i = 0; i < NPB; ++i) { const int row = 8 * (wave + 8 * i) + prow; bsrc[i] = Bt + (size_t)row * ldb + (((lane & 7) ^ ((row >> 1) & 7)) << 3); }
    const int KT = K / 64;
    const int fr = lane & 15, fq = lane >> 4;
    const int fsw = (lane >> 1) & 7;
#define G_DMA(kt_, st_) do { const int k0_ = (DIAG == 1) ? 0 : (kt_) * 64; LAS unsigned char* sb_ = lds + (st_) * STAGE; \
        _Pragma("unroll") for (int i = 0; i < 2; ++i) __builtin_amdgcn_global_load_lds((const __attribute__((address_space(1))) unsigned*)(asrc[i] + k0_), (LAS unsigned*)(sb_ + (wave + 8 * i) * 1024), 16, 0, A_AUX); \
        _Pragma("unroll") for (int i = 0; i < NPB; ++i) __builtin_amdgcn_global_load_lds((const __attribute__((address_space(1))) unsigned*)(bsrc[i] + k0_), (LAS unsigned*)(sb_ + A_BYTES + (wave + 8 * i) * 1024), 16, 0, 0); } while (0)
    G_DMA(0, 0);
    if (KT > 1) G_DMA(1, 1);
    int st = 0;
    for (int kt = 0; kt < KT; ++kt) {
        if (kt + 1 < KT) asm volatile("s_waitcnt vmcnt(%0)" :: "n"(NP) : "memory");
        else asm volatile("s_waitcnt vmcnt(0)" ::: "memory");
        asm volatile("s_waitcnt lgkmcnt(0)" ::: "memory");
        __builtin_amdgcn_s_barrier();
        if (kt + 2 < KT) { const int st2 = (st >= 1) ? st - 1 : 2; G_DMA(kt + 2, st2); }
        LAS unsigned char* la = lds + st * STAGE + (wm * 64 + fr) * 128;
        LAS unsigned char* lb = lds + st * STAGE + A_BYTES + (wn * (BN / 4) + fr) * 128;
#pragma unroll
        for (int kk = 0; kk < 2; ++kk) {
            const int choff = ((kk * 4 + fq) ^ fsw) << 4;
            bf16x8 af[4], bfr[NT];
#pragma unroll
            for (int i = 0; i < 4; ++i) af[i] = *(LAS bf16x8*)(la + i * 16 * 128 + choff);
#pragma unroll
            for (int j = 0; j < NT; ++j) bfr[j] = *(LAS bf16x8*)(lb + j * 16 * 128 + choff);
#pragma unroll
            for (int i = 0; i < 4; ++i)
#pragma unroll
                for (int j = 0; j < NT; ++j) {
                    if (TR) acc[i][j] = __builtin_amdgcn_mfma_f32_16x16x32_bf16(bfr[j], af[i], acc[i][j], 0, 0, 0);
                    else    acc[i][j] = __builtin_amdgcn_mfma_f32_16x16x32_bf16(af[i], bfr[j], acc[i][j], 0, 0, 0);
                }
        }
        st = (st == 2) ? 0 : st + 1;
    }
#undef G_DMA
    asm volatile("s_waitcnt lgkmcnt(0)" ::: "memory");
    __builtin_amdgcn_s_barrier();
#pragma unroll
    for (int i = 0; i < 4; ++i)
#pragma unroll
        for (int j = 0; j < NT; ++j) {
            if (TR) epi(wm * 64 + i * 16 + fr, wn * (BN / 4) + j * 16 + 4 * fq, acc[i][j]);
            else    epi(wm * 64 + i * 16 + 4 * fq, wn * (BN / 4) + j * 16 + fr, acc[i][j]);
        }
}

template <int BN, bool TR, int DIAG = 0, class Epi>
__device__ __forceinline__ void gemm_stream(const bf16_t* __restrict__ A, int lda, size_t a_cs, const bf16_t* __restrict__ Bt, int ldb, size_t b_cs,
                                            int K, int nchunks, LAS unsigned char* lds, const Epi& epi) {
    constexpr int NT = BN / 64;
    constexpr int NPB = BN / 64;
    constexpr int NP = 2 + NPB;
    constexpr int A_BYTES = 128 * 128;
    constexpr int B_BYTES = BN * 128;
    constexpr int STAGE = A_BYTES + B_BYTES;
    int tid = threadIdx.x;
    asm volatile("" : "+v"(tid));
    const int lane = tid & 63, wave = __builtin_amdgcn_readfirstlane(tid >> 6), wm = wave >> 2, wn = wave & 3;
    const int prow = lane >> 3;
    const bf16_t* asrc[2]; const bf16_t* bsrc[NPB];
#pragma unroll
    for (int i = 0; i < 2; ++i) { const int row = 8 * (wave + 8 * i) + prow; asrc[i] = A + (size_t)row * lda + (((lane & 7) ^ ((row >> 1) & 7)) << 3); }
#pragma unroll
    for (int i = 0; i < NPB; ++i) { const int row = 8 * (wave + 8 * i) + prow; bsrc[i] = Bt + (size_t)row * ldb + (((lane & 7) ^ ((row >> 1) & 7)) << 3); }
    const int KT = K / 64, NTILE = KT * nchunks;
    const int fr = lane & 15, fq = lane >> 4, fsw = (lane >> 1) & 7;
    const int aoff = (wm * 64 + fr) * 128, boff = A_BYTES + (wn * (BN / 4) + fr) * 128;
    int d_kt = 0, d_st = 0;
    int d_issued = 0;
#define GS_DMA() do { if (d_issued < NTILE && !(DIAG == 4 && d_issued >= 3)) { const int k0_ = (DIAG == 1) ? 0 : d_kt * 64; LAS unsigned char* sb_ = lds + d_st * STAGE; \
        _Pragma("unroll") for (int i = 0; i < 2; ++i) __builtin_amdgcn_global_load_lds((const __attribute__((address_space(1))) unsigned*)(asrc[i] + k0_), (LAS unsigned*)(sb_ + (wave + 8 * i) * 1024), 16, 0, 0); \
        _Pragma("unroll") for (int i = 0; i < NPB; ++i) __builtin_amdgcn_global_load_lds((const __attribute__((address_space(1))) unsigned*)(bsrc[i] + k0_), (LAS unsigned*)(sb_ + A_BYTES + (wave + 8 * i) * 1024), 16, 0, 0); \
        ++d_issued; d_st = (d_st == 2) ? 0 : d_st + 1; \
        if (++d_kt == KT) { d_kt = 0; _Pragma("unroll") for (int i = 0; i < 2; ++i) asrc[i] += a_cs; _Pragma("unroll") for (int i = 0; i < NPB; ++i) bsrc[i] += b_cs; } } } while (0)
#define GS_READ(AF, BF, st_, kk_) do { if (DIAG == 3) break; const int ch_ = (((kk_) * 4 + fq) ^ fsw) << 4; LAS unsigned char* sb_ = lds + (st_) * STAGE; \
        _Pragma("unroll") for (int i = 0; i < 4; ++i) AF[i] = *(LAS bf16x8*)(sb_ + aoff + i * 16 * 128 + ch_); \
        _Pragma("unroll") for (int j = 0; j < NT; ++j) BF[j] = *(LAS bf16x8*)(sb_ + boff + j * 16 * 128 + ch_); } while (0)
#define GS_MMA(AF, BF) do { if (DIAG == 2 || DIAG == 3) { _Pragma("unroll") for (int i = 0; i < 4; ++i) asm volatile("" :: "v"(AF[i])); _Pragma("unroll") for (int j = 0; j < NT; ++j) asm volatile("" :: "v"(BF[j])); break; } _Pragma("unroll") for (int i = 0; i < 4; ++i) _Pragma("unroll") for (int j = 0; j < NT; ++j) { \
        if (TR) acc[i][j] = __builtin_amdgcn_mfma_f32_16x16x32_bf16(BF[j], AF[i], acc[i][j], 0, 0, 0); \
        else    acc[i][j] = __builtin_amdgcn_mfma_f32_16x16x32_bf16(AF[i], BF[j], acc[i][j], 0, 0, 0); } } while (0)
    f32x4 acc[4][NT];
#pragma unroll
    for (int i = 0; i < 4; ++i)
#pragma unroll
        for (int j = 0; j < NT; ++j) acc[i][j] = (f32x4){0.f, 0.f, 0.f, 0.f};
    GS_DMA(); GS_DMA(); GS_DMA();
    if (NTILE >= 3) asm volatile("s_waitcnt vmcnt(%0)" :: "n"(2 * NP) : "memory");
    else if (NTILE == 2) asm volatile("s_waitcnt vmcnt(%0)" :: "n"(NP) : "memory");
    else asm volatile("s_waitcnt vmcnt(0)" ::: "memory");
    asm volatile("s_waitcnt lgkmcnt(0)" ::: "memory");
    __builtin_amdgcn_s_barrier();
    bf16x8 fa0[4] = {}, fb0[NT] = {}, fa1[4] = {}, fb1[NT] = {};
    GS_READ(fa0, fb0, 0, 0);
    int st = 0, kt = 0, chunk = 0;
    for (int t = 0; t < NTILE; ++t) {
        GS_READ(fa1, fb1, st, 1);
        GS_MMA(fa0, fb0);
        if (t + 2 < NTILE) asm volatile("s_waitcnt vmcnt(%0)" :: "n"(NP) : "memory");
        else asm volatile("s_waitcnt vmcnt(0)" ::: "memory");
        asm volatile("s_waitcnt lgkmcnt(0)" ::: "memory");
        __builtin_amdgcn_s_barrier();
        const int stn = (st == 2) ? 0 : st + 1;
        if (t + 1 < NTILE) GS_READ(fa0, fb0, stn, 0);
        GS_MMA(fa1, fb1);
        __builtin_amdgcn_sched_barrier(0);
        GS_DMA();
        __builtin_amdgcn_sched_barrier(0);
        st = stn;
        if (++kt == KT) {
            kt = 0;
#pragma unroll
            for (int i = 0; i < 4; ++i)
#pragma unroll
                for (int j = 0; j < NT; ++j) {
                    if (TR) epi(chunk, wm * 64 + i * 16 + fr, wn * (BN / 4) + j * 16 + 4 * fq, acc[i][j]);
                    else    epi(chunk, wm * 64 + i * 16 + 4 * fq, wn * (BN / 4) + j * 16 + fr, acc[i][j]);
                    acc[i][j] = (f32x4){0.f, 0.f, 0.f, 0.f};
                }
            ++chunk;
        }
    }
#undef GS_DMA
#undef GS_READ
#undef GS_MMA
}

__device__ __forceinline__ void rows_cvt_rstd(const float* __restrict__ src, bf16_t* __restrict__ dst, LAS float* rs) {
    int tid_ = threadIdx.x;
    asm volatile("" : "+v"(tid_));
    const int lane = tid_ & 63, wave = tid_ >> 6;
    for (int rb = 0; rb < 16; rb += 4) {
        float4 a[4][4];
#pragma unroll
        for (int i = 0; i < 4; ++i) {
            const float4* xr = (const float4*)(src + (size_t)(wave * 16 + rb + i) * 1024);
#pragma unroll
            for (int j = 0; j < 2; ++j) { a[i][2 * j] = xr[lane * 2 + 128 * j]; a[i][2 * j + 1] = xr[lane * 2 + 1 + 128 * j]; }
        }
        asm volatile("" ::: "memory");
#pragma unroll
        for (int i = 0; i < 4; ++i) {
            const int r = wave * 16 + rb + i;
            float ss = 0.f;
#pragma unroll
            for (int j = 0; j < 2; ++j) {
                const float4 u = a[i][2 * j], v = a[i][2 * j + 1];
                ss += u.x * u.x + u.y * u.y + u.z * u.z + u.w * u.w + v.x * v.x + v.y * v.y + v.z * v.z + v.w * v.w;
                *(u32x4*)(dst + (size_t)r * 1024 + lane * 8 + 512 * j) = (u32x4){pk2(u.x, u.y), pk2(u.z, u.w), pk2(v.x, v.y), pk2(v.z, v.w)};
            }
            ss = wave_sum(ss);
            if (lane == 0) rs[r] = rsqrtf(ss * (1.0f / 1024.0f) + EPS);
        }
    }
}
__device__ __forceinline__ void rows_rms512_inplace(bf16_t* base) {
    int tid_ = threadIdx.x;
    asm volatile("" : "+v"(tid_));
    const int lane = tid_ & 63, wave = tid_ >> 6;
    for (int rb = 0; rb < 16; rb += 8) {
        u32x4 w[8];
#pragma unroll
        for (int i = 0; i < 8; ++i) w[i] = *(const u32x4*)(base + (size_t)(wave * 16 + rb + i) * 1024 + lane * 8);
        asm volatile("" ::: "memory");
#pragma unroll
        for (int i = 0; i < 8; ++i) {
            const float f0 = bflo(w[i].x), f1 = bfhi(w[i].x), f2 = bflo(w[i].y), f3 = bfhi(w[i].y), f4 = bflo(w[i].z), f5 = bfhi(w[i].z), f6 = bflo(w[i].w), f7 = bfhi(w[i].w);
            float ss = f0 * f0 + f1 * f1 + f2 * f2 + f3 * f3 + f4 * f4 + f5 * f5 + f6 * f6 + f7 * f7;
            ss = wave_sum(ss);
            const float rr = rsqrtf(ss * (1.0f / 512.0f) + EPS);
            *(u32x4*)(base + (size_t)(wave * 16 + rb + i) * 1024 + lane * 8) = (u32x4){pk2(f0 * rr, f1 * rr), pk2(f2 * rr, f3 * rr), pk2(f4 * rr, f5 * rr), pk2(f6 * rr, f7 * rr)};
        }
    }
}

__device__ __forceinline__ void transpose_item(const float* __restrict__ W, int K, int N, bf16_t* __restrict__ WT,
                                               const float* __restrict__ g1, const float* __restrict__ g2, int split,
                                               LAS float* scr, int item, int lane) {
    const int nblk = N / 32, kb = item / nblk, nb = item % nblk, k0 = 64 * kb, n0 = 32 * nb;
#pragma unroll 8
    for (int i = 0; i < 32; ++i) {
        const int kk = 2 * i + (lane >> 5), k = k0 + kk;
        float w = W[(size_t)k * N + n0 + (lane & 31)];
        if (g1) w *= (k < split) ? g1[k] : g2[k - split];
        scr[kk * 33 + (lane & 31)] = w;
    }
    LDS_WAIT();
    const int c = lane & 7;
#pragma unroll
    for (int j = 0; j < 4; ++j) {
        const int n = (lane >> 3) + 8 * j;
        const LAS float* s = scr + (8 * c) * 33 + n;
        u32x4 o;
        o.x = pk2(s[0 * 33], s[1 * 33]); o.y = pk2(s[2 * 33], s[3 * 33]);
        o.z = pk2(s[4 * 33], s[5 * 33]); o.w = pk2(s[6 * 33], s[7 * 33]);
        *(u32x4*)(WT + (size_t)(n0 + n) * K + k0 + 8 * c) = o;
    }
    LDS_WAIT();
}

__device__ __forceinline__ void s5_tables(const Params& p, LAS unsigned char* lds, int g) {
    const int tid = threadIdx.x;
    LAS float* apr = (LAS float*)lds;
    LAS float* api = apr + 9 * 64;
    LAS float* bbr = api + 9 * 64;
    LAS float* bbi = bbr + 1024;
    LAS float* ccr = bbi + 1024;
    LAS float* cci = ccr + 1024;
    LAS float* kk = cci + 1024;
    const float* a_re = p.in[4]; const float* a_im = p.in[5]; const float* log_dt = p.in[6];
    const float* b_re = p.in[7]; const float* b_im = p.in[8]; const float* c_re = p.in[9]; const float* c_im = p.in[10];
    const float* dsk = p.in[11];
    float* PW = (float*)(p.ws + WS_PW) + (size_t)g * 17 * 128;
    bf16_t* TT = (bf16_t*)(p.ws + WS_TT) + (size_t)g * 128 * 256;
    bf16_t* WST = (bf16_t*)(p.ws + WS_WST) + (size_t)g * 128 * 128;
    if (tid < 64) {
        const int n = tid;
        const float lr = a_re[g * 64 + n], li = a_im[g * 64 + n], dt = expf(log_dt[g]);
        const float mag = expf(lr * dt), ang = li * dt;
        float rev = ang * 0.15915494309189535f;
        rev = rev - floorf(rev);
        const float ar = mag * __builtin_amdgcn_cosf(rev), ai = mag * __builtin_amdgcn_sinf(rev);
        float pr = 1.f, pi = 0.f;
        apr[n] = pr; api[n] = pi;
        for (int k = 1; k <= 8; ++k) {
            const float nr = pr * ar - pi * ai, ni = pr * ai + pi * ar;
            pr = nr; pi = ni; apr[k * 64 + n] = pr; api[k * 64 + n] = pi;
        }
        const float a8r = pr, a8i = pi;
        float qr = 1.f, qi = 0.f;
        for (int c = 0; c <= 16; ++c) {
            PW[c * 128 + n] = qr; PW[c * 128 + 64 + n] = qi;
            const float nr = qr * a8r - qi * a8i, ni = qr * a8i + qi * a8r;
            qr = nr; qi = ni;
        }
        const float nr = ar - 1.0f, ni = ai, den = lr * lr + li * li;
        const float cr = (nr * lr + ni * li) / den, ci = (ni * lr - nr * li) / den;
        for (int c2 = 0; c2 < 16; ++c2) {
            const float br = b_re[(size_t)(g * 64 + n) * 16 + c2], bi = b_im[(size_t)(g * 64 + n) * 16 + c2];
            bbr[n * 16 + c2] = cr * br - ci * bi;
            bbi[n * 16 + c2] = cr * bi + ci * br;
        }
    }
    for (int i = tid; i < 1024; i += NTHREADS) { ccr[i] = c_re[(size_t)g * 1024 + i]; cci[i] = c_im[(size_t)g * 1024 + i]; }
    __syncthreads();
    for (int e = tid; e < 2048; e += NTHREADS) {
        const int k = e >> 8, c = (e >> 4) & 15, c2 = e & 15;
        float s = 0.f;
        for (int n = 0; n < 64; ++n) {
            const float pr = apr[k * 64 + n], pi = api[k * 64 + n], br = bbr[n * 16 + c2], bi = bbi[n * 16 + c2];
            const float tr = pr * br - pi * bi, ti = pr * bi + pi * br;
            s += ccr[c * 64 + n] * tr - cci[c * 64 + n] * ti;
        }
        if (k == 0 && c == c2) s += dsk[g * 16 + c];
        kk[e] = s;
    }
    __syncthreads();
    for (int e = tid; e < 128 * 256; e += NTHREADS) {
        const int row = e >> 8, col = e & 255, tau = row >> 4, c = row & 15;
        float v;
        if (col < 128) {
            const int sg = col >> 4, c2 = col & 15;
            v = (tau >= sg) ? kk[((tau - sg) << 8) + (c << 4) + c2] : 0.f;
        } else {
            const int n = col & 63;
            const float pr = apr[(tau + 1) * 64 + n], pi = api[(tau + 1) * 64 + n];
            const float cr = ccr[c * 64 + n], ci = cci[c * 64 + n];
            v = (col < 192) ? (cr * pr - ci * pi) : -(cr * pi + ci * pr);
        }
        TT[e] = (bf16_t)f2bf(v);
    }
    for (int e = tid; e < 128 * 128; e += NTHREADS) {
        const int row = e >> 7, col = e & 127, part = row >> 6, n = row & 63, sg = col >> 4, c2 = col & 15;
        const float pr = apr[(7 - sg) * 64 + n], pi = api[(7 - sg) * 64 + n], br = bbr[n * 16 + c2], bi = bbi[n * 16 + c2];
        const float v = part ? (pr * bi + pi * br) : (pr * br - pi * bi);
        WST[e] = (bf16_t)f2bf(v);
    }
    __syncthreads();
}

__device__ __forceinline__ void phase0(const Params& p, LAS unsigned char* lds) {
    const int tid = threadIdx.x, lane = tid & 63, wave = tid >> 6;
    unsigned char* ws = p.ws;
    const int NB0 = (gridDim.x >= 64) ? 32 : (int)gridDim.x;
    const int cb0 = (NB0 != (int)gridDim.x) ? NB0 : 0;
    if ((int)blockIdx.x < NB0) {
        for (int g = blockIdx.x; g < NG; g += NB0) s5_tables(p, lds, g);
        if (cb0) return;
    }
    {
        LAS float* scr = (LAS float*)(lds + wave * 8448);
        const int gw = (blockIdx.x - cb0) * 8 + wave, ngw = (gridDim.x - cb0) * 8;
        constexpr int I0 = 16 * 48, I1 = 8 * 16, I2 = 16 * 32, I3 = 16 * 64, I4 = 16 * 32, I5 = 4 * 32;
        for (int it = gw; it < I0 + I1 + I2 + I3 + I4 + I5; it += ngw) {
            int r = it;
            if (r < I0) { transpose_item(p.in[3], 1024, 1536, (bf16_t*)(ws + WS_WIN), p.in[2], p.in[2], 1024, scr, r, lane); continue; } r -= I0;
            if (r < I1) { transpose_item(p.in[12], 512, 512, (bf16_t*)(ws + WS_WGLU), nullptr, nullptr, 0, scr, r, lane); continue; } r -= I1;
            if (r < I2) { transpose_item(p.in[20], 1024, 1024, (bf16_t*)(ws + WS_WOUT), p.in[18], p.in[19], 512, scr, r, lane); continue; } r -= I2;
            if (r < I3) { transpose_item(p.in[22], 1024, 2048, (bf16_t*)(ws + WS_WQ), p.in[21], p.in[21], 1024, scr, r, lane); continue; } r -= I3;
            if (r < I4) { transpose_item(p.in[27], 1024, 1024, (bf16_t*)(ws + WS_WGATE), p.in[26], p.in[26], 1024, scr, r, lane); continue; } r -= I4;
            transpose_item(p.in[28], 256, 1024, (bf16_t*)(ws + WS_WPROJ), nullptr, nullptr, 0, scr, r, lane);
        }
    }
    const size_t gt = (size_t)(blockIdx.x - cb0) * NTHREADS + tid, ngt = (size_t)(gridDim.x - cb0) * NTHREADS;
    {
        const float4* src = (const float4*)p.in[23]; u32x2* dst = (u32x2*)(ws + WS_KEYS);
        for (size_t i = gt; i < 65536; i += ngt) { const float4 v = src[i]; dst[i] = (u32x2){pk2(v.x, v.y), pk2(v.z, v.w)}; }
    }
    {
        const float4* src = (const float4*)p.in[16]; u32x2* dst = (u32x2*)(ws + WS_WSM);
        for (size_t i = gt; i < 16384; i += ngt) {
            float4 v = src[i];
            const int t = (int)((i >> 5) & 127), s0 = (int)(i & 31) * 4;
            if (s0 + 0 > t) v.x = 0.f; if (s0 + 1 > t) v.y = 0.f; if (s0 + 2 > t) v.z = 0.f; if (s0 + 3 > t) v.w = 0.f;
            dst[i] = (u32x2){pk2(v.x, v.y), pk2(v.z, v.w)};
        }
    }
    {
        const float4* su = (const float4*)p.in[24]; const float4* sv = (const float4*)p.in[25];
        const float4* g4 = (const float4*)p.in[21];
        unsigned* du = (unsigned*)(ws + WS_UTAB); unsigned* dv = (unsigned*)(ws + WS_VTAB);
        constexpr size_t NV4 = (size_t)16384 * 256;
        for (size_t i0 = gt; i0 < NV4; i0 += 8 * ngt) {
            float4 a[8], b[8];
#pragma unroll
            for (int k = 0; k < 8; ++k) { const size_t i = i0 + k * ngt; if (i < NV4) { a[k] = su[i]; b[k] = sv[i]; } }
            asm volatile("" ::: "memory");
#pragma unroll
            for (int k = 0; k < 8; ++k) {
                const size_t i = i0 + k * ngt;
                if (i < NV4) {
                    const float4 g = g4[i & 255];
                    int w = __builtin_amdgcn_cvt_pk_fp8_f32(a[k].x * g.x * 64.f, a[k].y * g.y * 64.f, 0, false);
                    w = __builtin_amdgcn_cvt_pk_fp8_f32(a[k].z * g.z * 64.f, a[k].w * g.w * 64.f, w, true);
                    du[i] = (unsigned)w;
                    w = __builtin_amdgcn_cvt_pk_fp8_f32(b[k].x * 4.f, b[k].y * 4.f, 0, false);
                    w = __builtin_amdgcn_cvt_pk_fp8_f32(b[k].z * 4.f, b[k].w * 4.f, w, true);
                    dv[i] = (unsigned)w;
                }
            }
        }
    }
}

__device__ __forceinline__ void phase1(const Params& p, LAS unsigned char* lds, int tile) {
    int tid = threadIdx.x;
    asm volatile("" : "+v"(tid));
    const int lane = tid & 63, wave = tid >> 6;
    unsigned char* ws = p.ws;
    const size_t tok0 = (size_t)tile * TILE;
    unsigned char* arena = ws + WS_ARENA + (size_t)tile * ARENA_BYTES;
    bf16_t* XB = (bf16_t*)(ws + WS_HB) + tok0 * 1024;
    bf16_t* XS = (bf16_t*)(arena + AR_XS);
    bf16_t* UG = (bf16_t*)(arena + AR_UG);
    bf16_t* GVT = (bf16_t*)(arena + AR_GV);
    float* HLOC = (float*)(arena + AR_HLOC);
    bf16_t* MIXA = (bf16_t*)(ws + WS_MIXA) + tok0 * 1024;
    LAS float* rs = (LAS float*)(lds + LDS_MISC);
    const float* x = p.in[0];

    rows_cvt_rstd(x + tok0 * 1024, XB, rs);
    __syncthreads();
    STAMP(20);

    const bf16_t* WIN = (const bf16_t*)(ws + WS_WIN);
    gemm_stream<256, true>(XB, 1024, 0, WIN, 1024, (size_t)256 * 1024, 1024, 4, lds, [=](int chunk, int row, int col, f32x4 v) {
        const float r = rs[row];
        const int gc = chunk * 256 + col;
        if (chunk < 2) {
            const int g = gc >> 4, c0 = gc & 15;
            *(u32x2*)(XS + ((size_t)g * 128 + row) * 16 + c0) = (u32x2){pk2(v[0] * r, v[1] * r), pk2(v[2] * r, v[3] * r)};
        } else {
            *(u32x2*)(UG + (size_t)row * 512 + (gc - 512)) = (u32x2){gelu_pk2(v[0] * r, v[1] * r), gelu_pk2(v[2] * r, v[3] * r)};
        }
    });
    gemm_stream<256, false>(XB, 1024, 0, WIN + (size_t)1024 * 1024, 1024, (size_t)256 * 1024, 1024, 2, lds, [=](int chunk, int row, int col, f32x4 v) {
        const int gc = chunk * 256 + col;
        *(u32x2*)(GVT + (size_t)gc * 128 + row) = (u32x2){gelu_pk2(v[0] * rs[row], v[1] * rs[row + 1]),
                                                          gelu_pk2(v[2] * rs[row + 2], v[3] * rs[row + 3])};
    });
    __syncthreads();
    STAMP(21);
#ifdef PROBE_DIAG
    {
        bf16_t* DUMP = (bf16_t*)(arena + AR_HLOC);
        gemm_stream<256, true, (PROBE_DIAG >= 10 ? 0 : PROBE_DIAG)>(XB, 1024, 0, WIN, 1024, (size_t)256 * 1024, 1024, 6, lds, [=](int chunk, int row, int col, f32x4 v) {
            if (PROBE_DIAG == 10) {
                const float r = rs[row];
                *(u32x2*)(DUMP + (size_t)row * 512 + ((chunk & 1) * 256 + col)) = (u32x2){gelu_pk2(v[0] * r, v[1] * r), gelu_pk2(v[2] * r, v[3] * r)};
            } else if (PROBE_DIAG == 11) {
                *(u32x2*)(DUMP + (size_t)row * 512 + ((chunk & 1) * 256 + col)) = (u32x2){pk2(v[0], v[1]), pk2(v[2], v[3])};
            } else if (PROBE_DIAG == 12) {
                const float r = rs[row];
                const unsigned a = gelu_pk2(v[0] * r, v[1] * r), b = gelu_pk2(v[2] * r, v[3] * r);
                if (a == 0x12345678u && b == 0x9abcdef0u) *(u32x2*)(DUMP + (size_t)row * 512 + col) = (u32x2){a, b};
            } else {
                if (v[0] == 123.456f) *(u32x2*)(DUMP + (size_t)row * 512 + (col & 255)) = (u32x2){pk2(v[0], v[1]), pk2(v[2], v[3])};
            }
        });
    }
    __syncthreads();
    STAMP(30);
#endif

    LAS float* stat = (LAS float*)lds;
    {
        const int s = tid & 127, head = tid >> 7;
        float sum = 0.f, sq = 0.f;
        for (int d = 0; d < 128; ++d) { const float v = bf2f(GVT[(size_t)(head * 128 + d) * 128 + s]); sum += v; sq += v * v; }
        const float mu = sum * (1.0f / 128.0f), var = sq * (1.0f / 128.0f) - mu * mu;
        stat[(head * 128 + s) * 2] = mu; stat[(head * 128 + s) * 2 + 1] = rsqrtf(fmaxf(var, 0.f) + EPS);
    }
    __syncthreads();
    {
        const float* lng = p.in[14]; const float* lnb = p.in[15];
        for (int c = tid; c < 8192; c += NTHREADS) {
            const int hd = c >> 4, s0 = (c & 15) * 8, head = hd >> 7;
            u32x4 w = *(u32x4*)(GVT + (size_t)hd * 128 + s0);
            const float g = lng[hd], b = lnb[hd];
            float o[8];
            const unsigned ww[4] = {w.x, w.y, w.z, w.w};
#pragma unroll
            for (int i = 0; i < 4; ++i) {
                const float mu0 = stat[(head * 128 + s0 + 2 * i) * 2], r0 = stat[(head * 128 + s0 + 2 * i) * 2 + 1];
                const float mu1 = stat[(head * 128 + s0 + 2 * i + 1) * 2], r1 = stat[(head * 128 + s0 + 2 * i + 1) * 2 + 1];
                o[2 * i] = (bflo(ww[i]) - mu0) * r0 * g + b;
                o[2 * i + 1] = (bfhi(ww[i]) - mu1) * r1 * g + b;
            }
            *(u32x4*)(GVT + (size_t)hd * 128 + s0) = (u32x4){pk2(o[0], o[1]), pk2(o[2], o[3]), pk2(o[4], o[5]), pk2(o[6], o[7])};
        }
    }
    __syncthreads();
    STAMP(22);

    {
        const bf16_t* WSM = (const bf16_t*)(ws + WS_WSM);
        const float* bs = p.in[17];
        gemm_stream<128, true>(WSM, 128, 16384, GVT, 128, 16384, 128, 4, lds, [=](int head, int row, int col, f32x4 v) {
            const float b = bs[head * 128 + row];
            const u32x2 uu = *(const u32x2*)(UG + (size_t)row * 512 + head * 128 + col);
            const float y0 = bflo(uu.x) * (v[0] + b), y1 = bfhi(uu.x) * (v[1] + b), y2 = bflo(uu.y) * (v[2] + b), y3 = bfhi(uu.y) * (v[3] + b);
            *(u32x2*)(MIXA + (size_t)row * 1024 + 512 + head * 128 + col) = (u32x2){pk2(y0, y1), pk2(y2, y3)};
        });
    }
    __syncthreads();
    STAMP(23);
    rows_rms512_inplace(MIXA + 512);
    STAMP(24);
    __syncthreads();
}

__device__ __forceinline__ void phaseS(const Params& p, LAS unsigned char* lds, int item) {
    int tid = threadIdx.x;
    asm volatile("" : "+v"(tid));
    const int lane = tid & 63, wave = tid >> 6, fr = lane & 15, fq = lane >> 4;
    unsigned char* ws = p.ws;
    const int g = item >> 3, pi = item & 7;
    const bf16_t* TTg = (const bf16_t*)(ws + WS_TT) + (size_t)g * 32768;
    const bf16_t* WSTg = (const bf16_t*)(ws + WS_WST) + (size_t)g * 16384;
    const float* PWg = (const float*)(ws + WS_PW) + (size_t)g * 17 * 128;
    LAS unsigned char* ltt = lds;
    LAS unsigned char* lsl = lds + 65536 + wave * 8192;
    LAS float* lst = (LAS float*)(lds + 131072);
#pragma unroll
    for (int i = 0; i < 8; ++i) {
        const int cid = tid + 512 * i, n = cid >> 5, c = cid & 31;
        const u32x4 v = *(const u32x4*)(TTg + (size_t)n * 256 + c * 8);
        *(LAS u32x4*)(ltt + n * 512 + ((c ^ (n & 15)) << 4)) = v;
    }
    const float a8r = PWg[128 + lane], a8i = PWg[128 + 64 + lane];
    const float a128r = PWg[16 * 128 + lane], a128i = PWg[16 * 128 + 64 + lane];
    float cr = 0.f, ci = 0.f;
    for (int r = 0; r < 4; ++r) {
        if ((r & 1) == 0) { cr = 0.f; ci = 0.f; }
        const int tile = ((2 * pi + (r >> 1)) << 4) + ((r & 1) << 3) + wave;
        unsigned char* arena = ws + WS_ARENA + (size_t)tile * ARENA_BYTES;
        const bf16_t* XS = (const bf16_t*)(arena + AR_XS) + (size_t)g * 2048;
        bf16_t* YS = (bf16_t*)(arena + AR_GV);
        const bf16_t* abase = XS + fr * 128 + fq * 8;
        f32x4 acc[8];
#pragma unroll
        for (int j = 0; j < 8; ++j) acc[j] = (f32x4){0.f, 0.f, 0.f, 0.f};
        bf16x8 afx[4];
#pragma unroll
        for (int ks = 0; ks < 4; ++ks) afx[ks] = *(const bf16x8*)(abase + ks * 32);
        {
            const bf16_t* bbase = WSTg + (size_t)fr * 128 + fq * 8;
#pragma unroll
            for (int ks = 0; ks < 4; ++ks)
#pragma unroll
                for (int j = 0; j < 8; ++j) {
                    const bf16x8 bfr = *(const bf16x8*)(bbase + (size_t)j * 16 * 128 + ks * 32);
                    acc[j] = __builtin_amdgcn_mfma_f32_16x16x32_bf16(bfr, afx[ks], acc[j], 0, 0, 0);
                }
        }
        __syncthreads();
#pragma unroll
        for (int j = 0; j < 8; ++j) *(LAS f32x4*)(lsl + fr * 512 + (16 * j + 4 * fq) * 4) = acc[j];
        LDS_WAIT();
        float sr[16], si[16], hlr[16], hli[16];
#pragma unroll
        for (int c = 0; c < 16; ++c) { sr[c] = *(LAS float*)(lsl + c * 512 + lane * 4); si[c] = *(LAS float*)(lsl + c * 512 + 256 + lane * 4); }
        float hr = 0.f, hi = 0.f;
#pragma unroll
        for (int c = 0; c < 16; ++c) {
            hlr[c] = hr; hli[c] = hi;
            const float nr = a8r * hr - a8i * hi + sr[c], ni = a8r * hi + a8i * hr + si[c];
            hr = nr; hi = ni;
        }
        lst[wave * 128 + lane] = hr; lst[wave * 128 + 64 + lane] = hi;
        __syncthreads();
        float Hr = cr, Hi = ci, Sr = 0.f, Si = 0.f;
#pragma unroll
        for (int w = 0; w < 8; ++w) {
            if (w == wave) { Sr = Hr; Si = Hi; }
            const float tr = lst[w * 128 + lane], ti = lst[w * 128 + 64 + lane];
            const float nr = a128r * Hr - a128i * Hi + tr, ni = a128r * Hi + a128i * Hr + ti;
            Hr = nr; Hi = ni;
        }
        cr = Hr; ci = Hi;
        {
            float pr = 1.f, pq = 0.f;
#pragma unroll
            for (int c = 0; c < 16; ++c) {
                const float vr = pr * Sr - pq * Si + hlr[c], vi = pr * Si + pq * Sr + hli[c];
                *(LAS bf16_t*)(lsl + c * 512 + ((((lane >> 3)) ^ c) << 4) + (lane & 7) * 2) = (bf16_t)f2bf(vr);
                *(LAS bf16_t*)(lsl + c * 512 + ((((64 + lane) >> 3) ^ c) << 4) + (lane & 7) * 2) = (bf16_t)f2bf(vi);
                const float nr = pr * a8r - pq * a8i, nq = pr * a8i + pq * a8r;
                pr = nr; pq = nq;
            }
        }
        LDS_WAIT();
#pragma unroll
        for (int j = 0; j < 8; ++j) acc[j] = (f32x4){0.f, 0.f, 0.f, 0.f};
#pragma unroll
        for (int ks = 0; ks < 8; ++ks) {
            bf16x8 af;
            if (ks < 4) af = afx[ks];
            else af = *(LAS bf16x8*)(lsl + fr * 512 + (((((ks - 4) * 4 + fq)) ^ fr) << 4));
#pragma unroll
            for (int j = 0; j < 8; ++j) {
                const int n = j * 16 + fr;
                const bf16x8 bfr = *(LAS bf16x8*)(ltt + n * 512 + (((ks * 4 + fq) ^ fr) << 4));
                acc[j] = __builtin_amdgcn_mfma_f32_16x16x32_bf16(bfr, af, acc[j], 0, 0, 0);
            }
        }
#pragma unroll
        for (int j = 0; j < 8; ++j) {
            const f32x4 v = acc[j];
            *(u32x2*)(YS + (size_t)(fr * 8 + j) * 512 + g * 16 + 4 * fq) = (u32x2){gelu_pk2(v[0], v[1]), gelu_pk2(v[2], v[3])};
        }
    }
    __syncthreads();
}

__device__ __forceinline__ void final_rows(const Params& p, size_t tok0) {
    int tid_ = threadIdx.x;
    asm volatile("" : "+v"(tid_));
    const int lane = tid_ & 63, wave = tid_ >> 6;
    const float4* g4 = (const float4*)p.in[29];
    float4 g[4];
#pragma unroll
    for (int j = 0; j < 4; ++j) g[j] = g4[lane + 64 * j];
    for (int rb = 0; rb < 16; rb += 4) {
        float4 v[4][4];
#pragma unroll
        for (int i = 0; i < 4; ++i) {
            const float4* hr = (const float4*)(p.out + (tok0 + wave * 16 + rb + i) * 1024);
#pragma unroll
            for (int j = 0; j < 4; ++j) v[i][j] = hr[lane + 64 * j];
        }
        asm volatile("" ::: "memory");
#pragma unroll
        for (int i = 0; i < 4; ++i) {
            float4* hr = (float4*)(p.out + (tok0 + wave * 16 + rb + i) * 1024);
            float ss = 0.f;
#pragma unroll
            for (int j = 0; j < 4; ++j) ss += v[i][j].x * v[i][j].x + v[i][j].y * v[i][j].y + v[i][j].z * v[i][j].z + v[i][j].w * v[i][j].w;
            ss = wave_sum(ss);
            const float rr = rsqrtf(ss * (1.0f / 1024.0f) + EPS);
#pragma unroll
            for (int j = 0; j < 4; ++j)
                hr[lane + 64 * j] = make_float4(v[i][j].x * rr * g[j].x, v[i][j].y * rr * g[j].y, v[i][j].z * rr * g[j].z, v[i][j].w * rr * g[j].w);
        }
    }
}

__device__ __forceinline__ unsigned ord_key(float f) { const unsigned u = __float_as_uint(f); return (u & 0x80000000u) ? ~u : (u | 0x80000000u); }
__device__ __forceinline__ float ord_val(unsigned k) { return (k & 0x80000000u) ? __uint_as_float(k & 0x7fffffffu) : __uint_as_float(~k); }

__device__ __forceinline__ void phase2(const Params& p, LAS unsigned char* lds, int tile) {
    int tid = threadIdx.x;
    asm volatile("" : "+v"(tid));
    const int lane = tid & 63, wave = tid >> 6;
    unsigned char* ws = p.ws;
    const size_t tok0 = (size_t)tile * TILE;
    unsigned char* arena = ws + WS_ARENA + (size_t)tile * ARENA_BYTES;
    bf16_t* HB = (bf16_t*)(ws + WS_HB) + tok0 * 1024;
    bf16_t* XS = (bf16_t*)(arena + AR_XS);
    float* HLOC = (float*)(arena + AR_HLOC);
    bf16_t* HI = (bf16_t*)(arena + AR_HI);
    bf16_t* YS = (bf16_t*)(arena + AR_GV);
    bf16_t* MIXA = (bf16_t*)(ws + WS_MIXA) + tok0 * 1024;
    float* OUT = p.out + tok0 * 1024;
    const float* x = p.in[0] + tok0 * 1024;
    LAS float* rs = (LAS float*)(lds + LDS_MISC);
    LAS float* rs2 = (LAS float*)(lds + LDS_MISC + 512);
    const float* PW = (const float*)(ws + WS_PW);

    {
        const bf16_t* WGLU = (const bf16_t*)(ws + WS_WGLU);
        const float* gb = p.in[13];
        gemm_stream<256, true>(YS, 512, 0, WGLU, 512, (size_t)256 * 512, 512, 2, lds, [=](int chunk, int row, int col, f32x4 v) {
            const int gc = chunk * 256 + col;
            const u32x2 yy = *(const u32x2*)(YS + (size_t)row * 512 + gc);
            const float4 b = *(const float4*)(gb + gc);
            const float y0 = bflo(yy.x) * sigmoid_f(v[0] + b.x), y1 = bfhi(yy.x) * sigmoid_f(v[1] + b.y);
            const float y2 = bflo(yy.y) * sigmoid_f(v[2] + b.z), y3 = bfhi(yy.y) * sigmoid_f(v[3] + b.w);
            *(u32x2*)(MIXA + (size_t)row * 1024 + gc) = (u32x2){pk2(y0, y1), pk2(y2, y3)};
        });
    }
    __syncthreads();
    STAMP(28);
    rows_rms512_inplace(MIXA);
    __syncthreads();
    STAMP(29);
    LAS float* rsq = (LAS float*)(lds + LDS_MISC + 1280);
    if (tid < TILE) rsq[tid] = 0.f;
    __syncthreads();
    {
        const bf16_t* WOUT = (const bf16_t*)(ws + WS_WOUT);
        gemm_stream<256, true>(MIXA, 1024, 0, WOUT, 1024, (size_t)256 * 1024, 1024, 4, lds, [=](int chunk, int row, int col, f32x4 v) {
            const int gc = chunk * 256 + col;
            const float4 xx = *(const float4*)(x + (size_t)row * 1024 + gc);
            const float h0 = xx.x + v[0], h1 = xx.y + v[1], h2 = xx.z + v[2], h3 = xx.w + v[3];
            *(u32x2*)(HB + (size_t)row * 1024 + gc) = (u32x2){pk2(h0, h1), pk2(h2, h3)};
            __hip_atomic_fetch_add(rsq + row, h0 * h0 + h1 * h1 + h2 * h2 + h3 * h3, __ATOMIC_RELAXED, __HIP_MEMORY_SCOPE_WORKGROUP);
        });
    }
    __syncthreads();
    STAMP(5);
    if (tid < TILE) rs[tid] = rsqrtf(rsq[tid] * (1.0f / 1024.0f) + EPS);
    __syncthreads();
    bf16_t* Q = (bf16_t*)(arena + AR_Q);
    {
        const bf16_t* WQ = (const bf16_t*)(ws + WS_WQ);
        gemm_stream<256, true>(HB, 1024, 0, WQ, 1024, (size_t)256 * 1024, 1024, 8, lds, [=](int chunk, int row, int col, f32x4 v) {
            const float r = rs[row];
            *(u32x2*)(Q + (size_t)row * 2048 + chunk * 256 + col) = (u32x2){pk2(v[0] * r, v[1] * r), pk2(v[2] * r, v[3] * r)};
        });
    }
    __syncthreads();
    STAMP(6);
    int* EIDX = (int*)(arena + AR_VNT);
    float* EGATE = (float*)(arena + AR_VNT + 65536);
    {
        const bf16_t* KEYS = (const bf16_t*)(ws + WS_KEYS);
        const int fr = lane & 15, fq = lane >> 4;
        const int wv = __builtin_amdgcn_readfirstlane(wave);
        LAS unsigned* lkey = (LAS unsigned*)(lds + 65536 + wv * 2048);
        const bf16_t* ksrc[4];
#pragma unroll
        for (int i = 0; i < 4; ++i) { const int row = 4 * (wv + 8 * i) + (lane >> 4); ksrc[i] = KEYS + (size_t)row * 128 + (((lane & 15) ^ (row & 15)) << 3); }
#define K_DMA(combo_, buf_) do { _Pragma("unroll") for (int i = 0; i < 4; ++i) \
        __builtin_amdgcn_global_load_lds((const __attribute__((address_space(1))) unsigned*)(ksrc[i] + (size_t)(combo_) * 16384), (LAS unsigned*)(lds + (buf_) * 32768 + (wv + 8 * i) * 1024), 16, 0, 0); } while (0)
        const bf16_t* qrow = Q + (size_t)(wv * 16 + fr) * 2048 + fq * 8;
        bf16x8 qa[4], qb[4];
        K_DMA(0, 0);
#pragma unroll
        for (int ks = 0; ks < 4; ++ks) qa[ks] = *(const bf16x8*)(qrow + ks * 32);
        unsigned S1[16];
#define CE(a_, b_) do { const unsigned hi_ = max(a_, b_), lo_ = min(a_, b_); a_ = hi_; b_ = lo_; } while (0)
#define SORT16(v_, o_) do { _Pragma("unroll") for (int p_ = 1; p_ < 16; p_ *= 2) _Pragma("unroll") for (int k_ = p_; k_ >= 1; k_ /= 2) \
        _Pragma("unroll") for (int j_ = k_ % p_; j_ <= 15 - k_; j_ += 2 * k_) _Pragma("unroll") for (int i_ = 0; i_ < k_; ++i_) \
            if (i_ + j_ + k_ <= 15 && (i_ + j_) / (2 * p_) == (i_ + j_ + k_) / (2 * p_)) CE(v_[(o_) + i_ + j_], v_[(o_) + i_ + j_ + k_]); } while (0)
#define BMERGE16(v_) do { _Pragma("unroll") for (int k_ = 8; k_ >= 1; k_ /= 2) _Pragma("unroll") for (int i_ = 0; i_ < 16; ++i_) \
        if ((i_ & k_) == 0) CE(v_[i_], v_[i_ + k_]); } while (0)
#define XMERGE16(v_, x_) do { unsigned o_[16]; _Pragma("unroll") for (int i_ = 0; i_ < 16; ++i_) o_[i_] = (unsigned)__shfl_xor((int)v_[15 - i_], x_); \
        _Pragma("unroll") for (int i_ = 0; i_ < 16; ++i_) v_[i_] = max(v_[i_], o_[i_]); BMERGE16(v_); } while (0)
        for (int head = 0; head < 8; ++head) {
#pragma unroll
            for (int kh = 0; kh < 2; ++kh) {
                const int combo = head * 2 + kh;
                asm volatile("s_waitcnt vmcnt(0)" ::: "memory");
                asm volatile("s_waitcnt lgkmcnt(0)" ::: "memory");
                __builtin_amdgcn_s_barrier();
                if (combo + 1 < 16) {
                    K_DMA(combo + 1, (combo + 1) & 1);
#pragma unroll
                    for (int ks = 0; ks < 4; ++ks) { if (kh == 0) qb[ks] = *(const bf16x8*)(qrow + (combo + 1) * 128 + ks * 32); else qa[ks] = *(const bf16x8*)(qrow + (combo + 1) * 128 + ks * 32); }
                }
                f32x4 acc[8];
#pragma unroll
                for (int j = 0; j < 8; ++j) acc[j] = (f32x4){0.f, 0.f, 0.f, 0.f};
                LAS unsigned char* kb = lds + (combo & 1) * 32768 + fr * 256;
#pragma unroll
                for (int ks = 0; ks < 4; ++ks) {
                    const bf16x8 af = (kh == 0) ? qa[ks] : qb[ks];
#pragma unroll
                    for (int j = 0; j < 8; ++j) {
                        const bf16x8 bfr = *(LAS bf16x8*)(kb + j * 16 * 256 + (((ks * 4 + fq) ^ fr) << 4));
                        acc[j] = __builtin_amdgcn_mfma_f32_16x16x32_bf16(bfr, af, acc[j], 0, 0, 0);
                    }
                }
                unsigned v[32];
#pragma unroll
                for (int j = 0; j < 8; ++j)
#pragma unroll
                    for (int r = 0; r < 4; ++r) v[4 * j + r] = (ord_key(acc[j][r]) & 0xFFFFFF80u) | (unsigned)(127 - (16 * j + 4 * fq + r));
                SORT16(v, 0);
                SORT16(v, 16);
                unsigned L[16];
#pragma unroll
                for (int i = 0; i < 16; ++i) L[i] = max(v[i], v[31 - i]);
                BMERGE16(L);
                XMERGE16(L, 16);
                XMERGE16(L, 32);
                if (kh == 0) {
#pragma unroll
                    for (int i = 0; i < 16; ++i) S1[i] = L[i];
                } else {
                    float s1[16], s2[16];
#pragma unroll
                    for (int i = 0; i < 16; ++i) { s1[i] = ord_val(S1[i] & 0xFFFFFF80u); s2[i] = ord_val(L[i] & 0xFFFFFF80u); }
                    unsigned c[16];
#pragma unroll
                    for (int i = 0; i < 16; ++i) c[i] = 0u;
                    {
                        int cnt = 0;
#pragma unroll
                        for (int a = 0; a < 16; ++a)
#pragma unroll
                            for (int b = 0; b < 16; ++b)
                                if ((a + 1) * (b + 1) <= 16) {
                                    const unsigned key = (ord_key(s1[a] + s2[b]) & 0xFFFFFF00u) | (unsigned)(255 - (a * 16 + b));
                                    if (fq == (cnt & 3)) c[cnt >> 2] = key;
                                    ++cnt;
                                }
                    }
                    SORT16(c, 0);
                    XMERGE16(c, 16);
                    XMERGE16(c, 32);
                    if (fq == 0) {
#pragma unroll
                        for (int i = 0; i < 4; ++i) {
                            *(LAS u32x4*)(lkey + fr * 32 + 4 * i) = (u32x4){S1[4 * i], S1[4 * i + 1], S1[4 * i + 2], S1[4 * i + 3]};
                            *(LAS u32x4*)(lkey + fr * 32 + 16 + 4 * i) = (u32x4){L[4 * i], L[4 * i + 1], L[4 * i + 2], L[4 * i + 3]};
                        }
                    }
                    float ev[16]; const float mx = ord_val(c[0] & 0xFFFFFF00u); float sum = 0.f;
#pragma unroll
                    for (int i = 0; i < 16; ++i) { ev[i] = __expf(ord_val(c[i] & 0xFFFFFF00u) - mx); sum += ev[i]; }
                    const float inv = 1.0f / sum;
                    LDS_WAIT();
                    int eo[4]; float go[4];
#pragma unroll
                    for (int i = 0; i < 4; ++i) {
                        const unsigned key = (fq == 0) ? c[i] : (fq == 1) ? c[4 + i] : (fq == 2) ? c[8 + i] : c[12 + i];
                        const float e = (fq == 0) ? ev[i] : (fq == 1) ? ev[4 + i] : (fq == 2) ? ev[8 + i] : ev[12 + i];
                        const int ab = 255 - (int)(key & 255u), a = ab >> 4, b = ab & 15;
                        const int i1 = 127 - (int)(lkey[fr * 32 + a] & 127u), i2 = 127 - (int)(lkey[fr * 32 + 16 + b] & 127u);
                        eo[i] = i1 * 128 + i2; go[i] = e * inv;
                    }
                    const int row = wv * 16 + fr;
#pragma unroll
                    for (int i = 0; i < 4; ++i) { const int e = head * 16 + 4 * fq + i; EIDX[(size_t)row * 128 + (e & 7) * 16 + (e >> 3)] = eo[i] << 10; }
                    *(float4*)(EGATE + (size_t)row * 128 + head * 16 + 4 * fq) = make_float4(go[0], go[1], go[2], go[3]);
                    LDS_WAIT();
                }
            }
        }
#undef K_DMA
    }
    __syncthreads();
    STAMP(8);
    if (tid < TILE) ((float*)(ws + WS_RSTD))[tok0 + tid] = rs[tid];
}

#define QUAD_GATHER16(dst, v4) do { \
        dst[0]  = __builtin_amdgcn_update_dpp(0, (int)v4.x, 0x00, 0xF, 0xF, true); dst[1]  = __builtin_amdgcn_update_dpp(0, (int)v4.y, 0x00, 0xF, 0xF, true); \
        dst[2]  = __builtin_amdgcn_update_dpp(0, (int)v4.z, 0x00, 0xF, 0xF, true); dst[3]  = __builtin_amdgcn_update_dpp(0, (int)v4.w, 0x00, 0xF, 0xF, true); \
        dst[4]  = __builtin_amdgcn_update_dpp(0, (int)v4.x, 0x55, 0xF, 0xF, true); dst[5]  = __builtin_amdgcn_update_dpp(0, (int)v4.y, 0x55, 0xF, 0xF, true); \
        dst[6]  = __builtin_amdgcn_update_dpp(0, (int)v4.z, 0x55, 0xF, 0xF, true); dst[7]  = __builtin_amdgcn_update_dpp(0, (int)v4.w, 0x55, 0xF, 0xF, true); \
        dst[8]  = __builtin_amdgcn_update_dpp(0, (int)v4.x, 0xAA, 0xF, 0xF, true); dst[9]  = __builtin_amdgcn_update_dpp(0, (int)v4.y, 0xAA, 0xF, 0xF, true); \
        dst[10] = __builtin_amdgcn_update_dpp(0, (int)v4.z, 0xAA, 0xF, 0xF, true); dst[11] = __builtin_amdgcn_update_dpp(0, (int)v4.w, 0xAA, 0xF, 0xF, true); \
        dst[12] = __builtin_amdgcn_update_dpp(0, (int)v4.x, 0xFF, 0xF, 0xF, true); dst[13] = __builtin_amdgcn_update_dpp(0, (int)v4.y, 0xFF, 0xF, 0xF, true); \
        dst[14] = __builtin_amdgcn_update_dpp(0, (int)v4.z, 0xFF, 0xF, 0xF, true); dst[15] = __builtin_amdgcn_update_dpp(0, (int)v4.w, 0xFF, 0xF, 0xF, true); } while (0)

__device__ __forceinline__ void peer_u_item(const Params& p, int tile, int j) {
    int tid = threadIdx.x;
    asm volatile("" : "+v"(tid));
    const int lane = tid & 63, wave = tid >> 6, q = lane & 7, g = lane >> 3;
    unsigned char* ws = p.ws;
    const size_t tok0 = (size_t)tile * TILE;
    unsigned char* arena = ws + WS_ARENA + (size_t)tile * ARENA_BYTES;
    const bf16_t* HB = (const bf16_t*)(ws + WS_HB) + (tok0 + wave * 16) * 1024 + j * 128 + q * 16;
    const u32x4* EIDT = (const u32x4*)((const int*)(arena + AR_VNT) + (size_t)(wave * 16) * 128 + g * 16 + 4 * (q & 3));
    float* PD = (float*)(arena + AR_Q) + ((size_t)(wave * 16) * 8 + j) * 128 + 8 * q + g;
    const __amdgpu_buffer_rsrc_t ursrc = __builtin_amdgcn_make_buffer_rsrc(ws + WS_UTAB, 0, 16384 * 1024, 0x00020000);
    u32x4 i4 = EIDT[0];
    for (int tt = 0; tt < 16; ++tt) {
        int idx[16];
        QUAD_GATHER16(idx, i4);
        const u32x4 xa = *(const u32x4*)(HB + (size_t)tt * 1024), xb = *(const u32x4*)(HB + (size_t)tt * 1024 + 8);
        u32x4 w[16];
#pragma unroll
        for (int it = 0; it < 16; ++it) w[it] = __builtin_amdgcn_raw_buffer_load_b128(ursrc, idx[it] + q * 16, j * 128, 0);
        if (tt + 1 < 16) i4 = EIDT[(size_t)(tt + 1) * 32];
        asm volatile("" ::: "memory");
        f32x2 x2[8];
        x2[0] = (f32x2){bflo(xa.x), bfhi(xa.x)}; x2[1] = (f32x2){bflo(xa.y), bfhi(xa.y)}; x2[2] = (f32x2){bflo(xa.z), bfhi(xa.z)}; x2[3] = (f32x2){bflo(xa.w), bfhi(xa.w)};
        x2[4] = (f32x2){bflo(xb.x), bfhi(xb.x)}; x2[5] = (f32x2){bflo(xb.y), bfhi(xb.y)}; x2[6] = (f32x2){bflo(xb.z), bfhi(xb.z)}; x2[7] = (f32x2){bflo(xb.w), bfhi(xb.w)};
        float r0 = 0.f, r1 = 0.f;
#pragma unroll
        for (int it = 0; it < 16; ++it) {
            f32x2 acc = {0.f, 0.f};
            acc = __builtin_amdgcn_cvt_pk_f32_fp8(w[it].x, false) * x2[0] + acc; acc = __builtin_amdgcn_cvt_pk_f32_fp8(w[it].x, true) * x2[1] + acc;
            acc = __builtin_amdgcn_cvt_pk_f32_fp8(w[it].y, false) * x2[2] + acc; acc = __builtin_amdgcn_cvt_pk_f32_fp8(w[it].y, true) * x2[3] + acc;
            acc = __builtin_amdgcn_cvt_pk_f32_fp8(w[it].z, false) * x2[4] + acc; acc = __builtin_amdgcn_cvt_pk_f32_fp8(w[it].z, true) * x2[5] + acc;
            acc = __builtin_amdgcn_cvt_pk_f32_fp8(w[it].w, false) * x2[6] + acc; acc = __builtin_amdgcn_cvt_pk_f32_fp8(w[it].w, true) * x2[7] + acc;
            float sdot = acc.x + acc.y;
            sdot += DPP_F(sdot, 0xB1); sdot += DPP_F(sdot, 0x4E); sdot += DPP_F(sdot, 0x141);
            if (q == (it & 7)) { if (it < 8) r0 = sdot; else r1 = sdot; }
        }
        float* pd = PD + (size_t)tt * 8 * 128;
        pd[0] = r0; pd[64] = r1;
    }
}

__device__ __forceinline__ void peer_act(const Params& p, int tile) {
    int tid = threadIdx.x;
    asm volatile("" : "+v"(tid));
    const int lane = tid & 63, wave = tid >> 6;
    unsigned char* ws = p.ws;
    const size_t tok0 = (size_t)tile * TILE;
    unsigned char* arena = ws + WS_ARENA + (size_t)tile * ARENA_BYTES;
    const float* EGATE = (const float*)(arena + AR_VNT + 65536);
    const float* PD = (const float*)(arena + AR_Q);
    const float* RSTD = (const float*)(ws + WS_RSTD) + tok0;
    float* ACT = (float*)(arena + AR_GV);
    const int p0 = (lane & 7) * 16 + (lane >> 3), p1 = p0 + 8;
    for (int rb = 0; rb < 16; rb += 4) {
        float pd[4][16]; float gt[4][2]; float rsd[4];
#pragma unroll
        for (int i = 0; i < 4; ++i) {
            const int row = wave * 16 + rb + i;
#pragma unroll
            for (int jj = 0; jj < 8; ++jj) { pd[i][2 * jj] = PD[((size_t)row * 8 + jj) * 128 + lane]; pd[i][2 * jj + 1] = PD[((size_t)row * 8 + jj) * 128 + 64 + lane]; }
            gt[i][0] = EGATE[(size_t)row * 128 + lane]; gt[i][1] = EGATE[(size_t)row * 128 + 64 + lane];
            rsd[i] = RSTD[row];
        }
        asm volatile("" ::: "memory");
#pragma unroll
        for (int i = 0; i < 4; ++i) {
            const int row = wave * 16 + rb + i;
            const float sc = rsd[i] * (1.0f / 64.0f);
            float s0 = 0.f, s1 = 0.f;
#pragma unroll
            for (int jj = 0; jj < 8; ++jj) { s0 += pd[i][2 * jj]; s1 += pd[i][2 * jj + 1]; }
            ACT[(size_t)row * 128 + p0] = gelu_f(s0 * sc) * gt[i][0] * 0.25f;
            ACT[(size_t)row * 128 + p1] = gelu_f(s1 * sc) * gt[i][1] * 0.25f;
        }
    }
}

__device__ __forceinline__ void peer_v_item(const Params& p, int tile, int j) {
    int tid = threadIdx.x;
    asm volatile("" : "+v"(tid));
    const int lane = tid & 63, wave = tid >> 6, q = lane & 7, g = lane >> 3;
    unsigned char* ws = p.ws;
    const size_t tok0 = (size_t)tile * TILE;
    unsigned char* arena = ws + WS_ARENA + (size_t)tile * ARENA_BYTES;
    const bool b5 = (lane & 32) != 0, b4 = (lane & 16) != 0, b3 = (lane & 8) != 0;
    const int col = j * 128 + q * 16 + (b5 ? 8 : 0) + (b4 ? 4 : 0) + (b3 ? 2 : 0);
    bf16_t* HB = (bf16_t*)(ws + WS_HB) + (tok0 + wave * 16) * 1024 + col;
    const u32x4* EIDT = (const u32x4*)((const int*)(arena + AR_VNT) + (size_t)(wave * 16) * 128 + g * 16 + 4 * (q & 3));
    const u32x4* ACTT = (const u32x4*)((const float*)(arena + AR_GV) + (size_t)(wave * 16) * 128 + g * 16 + 4 * (q & 3));
    float* SSQ = (float*)(ws + WS_SSQ) + (tok0 + wave * 16) * 8 + j;
    const __amdgpu_buffer_rsrc_t vrsrc = __builtin_amdgcn_make_buffer_rsrc(ws + WS_VTAB, 0, 16384 * 1024, 0x00020000);
    u32x4 i4, a4a, a4b;
    u32x4 w0[16], w1[16];
    unsigned h0, h1;
#define PV_ENT(t_) do { i4 = EIDT[(size_t)(t_) * 32]; } while (0)
#define PV_GATHER(W, A4, H, t_) do { int idx_[16]; QUAD_GATHER16(idx_, i4); \
        _Pragma("unroll") for (int it = 0; it < 16; ++it) W[it] = __builtin_amdgcn_raw_buffer_load_b128(vrsrc, idx_[it] + q * 16, j * 128, 0); \
        A4 = ACTT[(size_t)(t_) * 32]; H = *(const unsigned*)(HB + (size_t)(t_) * 1024); } while (0)
#define PV_COMPUTE(W, A4, H, t_) do { \
        int avi_[16]; QUAD_GATHER16(avi_, A4); \
        f32x2 y2[8]; \
        _Pragma("unroll") for (int i = 0; i < 8; ++i) y2[i] = (f32x2){0.f, 0.f}; \
        _Pragma("unroll") for (int it = 0; it < 16; ++it) { \
            const float a_ = __builtin_bit_cast(float, avi_[it]); const f32x2 a2 = {a_, a_}; \
            y2[0] = __builtin_amdgcn_cvt_pk_f32_fp8(W[it].x, false) * a2 + y2[0]; y2[1] = __builtin_amdgcn_cvt_pk_f32_fp8(W[it].x, true) * a2 + y2[1]; \
            y2[2] = __builtin_amdgcn_cvt_pk_f32_fp8(W[it].y, false) * a2 + y2[2]; y2[3] = __builtin_amdgcn_cvt_pk_f32_fp8(W[it].y, true) * a2 + y2[3]; \
            y2[4] = __builtin_amdgcn_cvt_pk_f32_fp8(W[it].z, false) * a2 + y2[4]; y2[5] = __builtin_amdgcn_cvt_pk_f32_fp8(W[it].z, true) * a2 + y2[5]; \
            y2[6] = __builtin_amdgcn_cvt_pk_f32_fp8(W[it].w, false) * a2 + y2[6]; y2[7] = __builtin_amdgcn_cvt_pk_f32_fp8(W[it].w, true) * a2 + y2[7]; \
        } \
          \
        f32x2 k4[4]; \
        _Pragma("unroll") for (int i = 0; i < 4; ++i) { \
            const auto rx = __builtin_amdgcn_permlane32_swap(__float_as_uint(y2[i].x), __float_as_uint(y2[4 + i].x), false, false); \
            const auto ry = __builtin_amdgcn_permlane32_swap(__float_as_uint(y2[i].y), __float_as_uint(y2[4 + i].y), false, false); \
            k4[i] = (f32x2){__uint_as_float(rx[0]) + __uint_as_float(rx[1]), __uint_as_float(ry[0]) + __uint_as_float(ry[1])}; \
        } \
        f32x2 k2[2]; \
        _Pragma("unroll") for (int i = 0; i < 2; ++i) { \
            const auto rx = __builtin_amdgcn_permlane16_swap(__float_as_uint(k4[i].x), __float_as_uint(k4[2 + i].x), false, false); \
            const auto ry = __builtin_amdgcn_permlane16_swap(__float_as_uint(k4[i].y), __float_as_uint(k4[2 + i].y), false, false); \
            k2[i] = (f32x2){__uint_as_float(rx[0]) + __uint_as_float(rx[1]), __uint_as_float(ry[0]) + __uint_as_float(ry[1])}; \
        } \
        const f32x2 keep = b3 ? k2[1] : k2[0], send = b3 ? k2[0] : k2[1]; \
        const float h20 = bflo(H) + keep.x + __shfl_xor(send.x, 8), h21 = bfhi(H) + keep.y + __shfl_xor(send.y, 8); \
        *(unsigned*)(HB + (size_t)(t_) * 1024) = pk2(h20, h21); \
        const float ss = wave_sum(h20 * h20 + h21 * h21); \
        if (lane == 0) SSQ[(t_) * 8] = ss; } while (0)
    PV_ENT(0);
    PV_GATHER(w0, a4a, h0, 0);
    asm volatile("" ::: "memory");
    PV_ENT(1);
    asm volatile("" ::: "memory");
    for (int tt = 0; tt < 16; tt += 2) {
        PV_GATHER(w1, a4b, h1, tt + 1);
        asm volatile("" ::: "memory");
        if (tt + 2 < 16) PV_ENT(tt + 2);
        asm volatile("" ::: "memory");
        PV_COMPUTE(w0, a4a, h0, tt);
        if (tt + 2 < 16) {
            PV_GATHER(w0, a4a, h0, tt + 2);
            asm volatile("" ::: "memory");
            PV_ENT(tt + 3);
        }
        asm volatile("" ::: "memory");
        PV_COMPUTE(w1, a4b, h1, tt + 1);
    }
#undef PV_ENT
#undef PV_GATHER
#undef PV_COMPUTE
}

__device__ __forceinline__ void phase5(const Params& p, LAS unsigned char* lds, int tile) {
    int tid = threadIdx.x;
    asm volatile("" : "+v"(tid));
    const int lane = tid & 63, wave = tid >> 6;
    unsigned char* ws = p.ws;
    const size_t tok0 = (size_t)tile * TILE;
    unsigned char* arena = ws + WS_ARENA + (size_t)tile * ARENA_BYTES;
    bf16_t* HB = (bf16_t*)(ws + WS_HB) + tok0 * 1024;
    LAS float* rs2 = (LAS float*)(lds + LDS_MISC + 512);
    if (tid < TILE) {
        const float* sq = (const float*)(ws + WS_SSQ) + (tok0 + tid) * 8;
        float ss = 0.f;
#pragma unroll
        for (int jj = 0; jj < 8; ++jj) ss += sq[jj];
        rs2[tid] = rsqrtf(ss * (1.0f / 1024.0f) + EPS);
    }
    bf16_t* PB = (bf16_t*)(arena + AR_HI);
    {
        const float* pp = p.in[1] + tok0 * 256;
        for (int r = wave; r < TILE; r += 8) {
            const float4 v = *(const float4*)(pp + (size_t)r * 256 + lane * 4);
            *(u32x2*)(PB + (size_t)r * 256 + lane * 4) = (u32x2){pk2(v.x, v.y), pk2(v.z, v.w)};
        }
    }
    __syncthreads();
    bf16_t* PP = (bf16_t*)(arena + AR_PP);
    {
        const bf16_t* WPROJ = (const bf16_t*)(ws + WS_WPROJ);
        gemm_stream<256, true>(PB, 256, 0, WPROJ, 256, (size_t)256 * 256, 256, 4, lds, [=](int chunk, int row, int col, f32x4 v) {
            *(u32x2*)(PP + (size_t)row * 1024 + chunk * 256 + col) = (u32x2){pk2(v[0], v[1]), pk2(v[2], v[3])};
        });
    }
    __syncthreads();
    LAS float* rsq = (LAS float*)(lds + LDS_MISC + 1280);
    if (tid < TILE) rsq[tid] = 0.f;
    __syncthreads();
    {
        const bf16_t* WGATE = (const bf16_t*)(ws + WS_WGATE);
        gemm_stream<256, true>(HB, 1024, 0, WGATE, 1024, (size_t)256 * 1024, 1024, 4, lds, [=](int chunk, int row, int col, f32x4 v) {
            const float r = rs2[row];
            const int gc = chunk * 256 + col;
            const u32x2 pv = *(const u32x2*)(PP + (size_t)row * 1024 + gc);
            const u32x2 hv = *(const u32x2*)(HB + (size_t)row * 1024 + gc);
            const float h0 = bflo(hv.x) + sigmoid_f(v[0] * r) * bflo(pv.x), h1 = bfhi(hv.x) + sigmoid_f(v[1] * r) * bfhi(pv.x);
            const float h2 = bflo(hv.y) + sigmoid_f(v[2] * r) * bflo(pv.y), h3 = bfhi(hv.y) + sigmoid_f(v[3] * r) * bfhi(pv.y);
            *(u32x2*)(PP + (size_t)row * 1024 + gc) = (u32x2){pk2(h0, h1), pk2(h2, h3)};
            __hip_atomic_fetch_add(rsq + row, h0 * h0 + h1 * h1 + h2 * h2 + h3 * h3, __ATOMIC_RELAXED, __HIP_MEMORY_SCOPE_WORKGROUP);
        });
    }
    __syncthreads();
    STAMP(10);
    {
        float* OUT = p.out + tok0 * 1024;
        const float4* g4 = (const float4*)p.in[29];
        float4 g[4];
#pragma unroll
        for (int j = 0; j < 2; ++j) { g[2 * j] = g4[lane * 2 + 128 * j]; g[2 * j + 1] = g4[lane * 2 + 1 + 128 * j]; }
        for (int rb = 0; rb < 16; rb += 8) {
            u32x4 hv[8][2];
#pragma unroll
            for (int i = 0; i < 8; ++i)
#pragma unroll
                for (int j = 0; j < 2; ++j) hv[i][j] = *(const u32x4*)(PP + (size_t)(wave * 16 + rb + i) * 1024 + lane * 8 + 512 * j);
            asm volatile("" ::: "memory");
#pragma unroll
            for (int i = 0; i < 8; ++i) {
                const int row = wave * 16 + rb + i;
                const float rr = rsqrtf(rsq[row] * (1.0f / 1024.0f) + EPS);
#pragma unroll
                for (int j = 0; j < 2; ++j) {
                    const u32x4 w = hv[i][j];
                    float4* o = (float4*)(OUT + (size_t)row * 1024 + lane * 8 + 512 * j);
                    o[0] = make_float4(bflo(w.x) * rr * g[2 * j].x, bfhi(w.x) * rr * g[2 * j].y, bflo(w.y) * rr * g[2 * j].z, bfhi(w.y) * rr * g[2 * j].w);
                    o[1] = make_float4(bflo(w.z) * rr * g[2 * j + 1].x, bfhi(w.z) * rr * g[2 * j + 1].y, bflo(w.w) * rr * g[2 * j + 1].z, bfhi(w.w) * rr * g[2 * j + 1].w);
                }
            }
        }
    }
    __syncthreads();
    STAMP(11);
}

#define XB_TMO      128
#define XB_XCNT(j)  (256  + 64 * (j))
#define XB_XSUB(j)  (1280 + 64 * (j))
#define XB_XGEN(j)  (2304 + 64 * (j))
#define XB_TOP      3328
#define XB_TOPGEN   3392
#define XCD_BAR_WORDS 3456
#define XB_SPIN_CAP (1u << 22)
__device__ __forceinline__ unsigned xb_ld(unsigned* p)              { return __hip_atomic_load(p, __ATOMIC_RELAXED, __HIP_MEMORY_SCOPE_AGENT); }
__device__ __forceinline__ unsigned xb_add(unsigned* p, unsigned v) { return __hip_atomic_fetch_add(p, v, __ATOMIC_RELAXED, __HIP_MEMORY_SCOPE_AGENT); }
__device__ __forceinline__ unsigned xb_xcc_id() { return (unsigned)__builtin_amdgcn_s_getreg((3 << 11) | 20) & 0xFu; }
#define XB_SPIN(cond, bar) do { unsigned _sp = 0; while (cond) { __builtin_amdgcn_s_sleep(1); \
    if ((++_sp & 255u) == 0u) { if (xb_ld(&(bar)[XB_TMO])) break; if (_sp > XB_SPIN_CAP) { atomicAdd(&(bar)[XB_TMO], 1u); break; } } } } while (0)
struct XcdBarrier { unsigned* bar; unsigned x; volatile LAS unsigned* st; };
__device__ __forceinline__ XcdBarrier xcd_barrier_post(unsigned* bar, volatile LAS unsigned* st) {
    XcdBarrier b; b.bar = bar; b.x = xb_xcc_id(); b.st = st;
    if (threadIdx.x == 0) (void)xb_add(&bar[XB_XCNT(b.x)], 1u);
    return b;
}
__device__ __forceinline__ void xcd_barrier_complete(unsigned* bar, unsigned x, unsigned& nloc, unsigned& nx) {
    const unsigned G = gridDim.x * gridDim.y * gridDim.z;
    unsigned sum, cnt, mine, sp = 0u;
    for (;;) {
        sum = 0u; cnt = 0u; mine = 0u;
#pragma unroll
        for (unsigned j = 0; j < 16; ++j) { const unsigned c = xb_ld(&bar[XB_XCNT(j)]); sum += c; cnt += (c > 0u) ? 1u : 0u; mine = (j == x) ? c : mine; }
        if (sum == G) break;
        __builtin_amdgcn_s_sleep(1);
        if ((++sp & 255u) == 0u) { if (xb_ld(&bar[XB_TMO])) break; if (sp > XB_SPIN_CAP) { atomicAdd(&bar[XB_TMO], 1u); break; } }
    }
    nloc = mine > 0u ? mine : 1u; nx = cnt > 0u ? cnt : 1u;
}
__device__ __forceinline__ void xcd_barrier(const XcdBarrier& b) {
    asm volatile("s_waitcnt vmcnt(0)" ::: "memory");
    __syncthreads();
    if (threadIdx.x == 0) {
        unsigned* bar = b.bar;
        __builtin_amdgcn_s_waitcnt(0);
        unsigned nloc = b.st[0], nx = b.st[1];
        if (nloc == 0u) { xcd_barrier_complete(bar, b.x, nloc, nx); b.st[0] = nloc; b.st[1] = nx; }
        const unsigned old = xb_add(&bar[XB_XSUB(b.x)], 1u);
        const unsigned gen = old / nloc;
        if (old + 1u == (gen + 1u) * nloc) {
            __builtin_amdgcn_fence(__ATOMIC_RELEASE, "agent");
            asm volatile("s_waitcnt vmcnt(0)" ::: "memory");
            const unsigned og = xb_add(&bar[XB_TOP], 1u);
            const unsigned tg = og / nx;
            if (og + 1u == (tg + 1u) * nx) xb_add(&bar[XB_TOPGEN], 1u);
            else XB_SPIN(xb_ld(&bar[XB_TOPGEN]) == tg, bar);
            __builtin_amdgcn_fence(__ATOMIC_ACQUIRE, "agent");
            xb_add(&bar[XB_XGEN(b.x)], 1u);
            asm volatile("s_waitcnt vmcnt(0)" ::: "memory");
        } else {
            XB_SPIN(xb_ld(&bar[XB_XGEN(b.x)]) == gen, bar);
            __builtin_amdgcn_fence(__ATOMIC_ACQUIRE, "agent");
            asm volatile("s_waitcnt vmcnt(0)" ::: "memory");
        }
    }
    __syncthreads();
}

__global__ void __launch_bounds__(NTHREADS) fwd_kernel(Params p) {
    __shared__ __attribute__((aligned(16))) unsigned char lds_raw[LDS_BYTES];
    LAS unsigned char* lds = (LAS unsigned char*)lds_raw;
    cg::grid_group grid = cg::this_grid();
    volatile LAS unsigned* bst = (volatile LAS unsigned*)(lds + LDS_MISC + 1024);
    if (threadIdx.x == 0) { bst[0] = 0u; bst[1] = 0u; }
    __syncthreads();
    XcdBarrier bar = xcd_barrier_post((unsigned*)(p.ws + WS_BAR), bst);
    STAMP(0);
#ifdef PROBE_A
    if (blockIdx.x == 0 && threadIdx.x == 0) *(unsigned*)(p.ws + WS_END) = 0u;
#endif
    phase0(p, lds);
    STAMP(1);
    grid.sync();
    STAMP(2);
    for (int tile = blockIdx.x; tile < NTILES; tile += gridDim.x) phase1(p, lds, tile);
    STAMP(3);
    xcd_barrier(bar);
    STAMP(4);
    for (int it = blockIdx.x; it < NG * 8; it += gridDim.x) phaseS(p, lds, it);
    STAMP(18);
    xcd_barrier(bar);
    STAMP(19);
    for (int tile = blockIdx.x; tile < NTILES; tile += gridDim.x) phase2(p, lds, tile);
    STAMP(12);
    xcd_barrier(bar);
    STAMP(13);
    for (int it = blockIdx.x; it < NTILES * 8; it += gridDim.x) peer_u_item(p, it >> 3, it & 7);
    STAMP(14);
    xcd_barrier(bar);
    for (int tile = blockIdx.x; tile < NTILES; tile += gridDim.x) peer_act(p, tile);
    xcd_barrier(bar);
    STAMP(15);
    for (int it = blockIdx.x; it < NTILES * 8; it += gridDim.x) peer_v_item(p, it >> 3, it & 7);
    STAMP(16);
    xcd_barrier(bar);
    STAMP(17);
    for (int tile = blockIdx.x; tile < NTILES; tile += gridDim.x) phase5(p, lds, tile);
#ifdef PROBE_A
    {
        LAS unsigned long long* ts = (LAS unsigned long long*)(lds + LDS_MISC + 2048);
        unsigned* mx = (unsigned*)(p.ws + WS_END);
        if (threadIdx.x == 0) atomicMax(mx, (unsigned)(ts[PROBE_B] - ts[PROBE_A]));
        grid.sync();
        if (blockIdx.x == 0 && threadIdx.x == 0) {
            const unsigned long long dly = (unsigned long long)__hip_atomic_load(mx, __ATOMIC_RELAXED, __HIP_MEMORY_SCOPE_AGENT) * PROBE_MUL, t_end = __builtin_amdgcn_s_memrealtime();
            while (__builtin_amdgcn_s_memrealtime() - t_end < dly) __builtin_amdgcn_s_sleep(8);
        }
    }
#endif
}

extern "C" void kernel_launch(void* const* d_in, const int* in_sizes, int n_in, void* d_out, int out_size, void* d_ws, size_t ws_size,
                              hipStream_t stream) {
    static int grid_blocks = 0;
    if (!grid_blocks) {
        int dev = 0, cus = 0, per_cu = 0;
        (void)hipGetDevice(&dev);
        (void)hipDeviceGetAttribute(&cus, hipDeviceAttributeMultiprocessorCount, dev);
        (void)hipOccupancyMaxActiveBlocksPerMultiprocessor(&per_cu, fwd_kernel, NTHREADS, 0);
        if (per_cu < 1) { fprintf(stderr, "kernel_launch: occupancy query says %d blocks per CU\n", per_cu); per_cu = 1; }
        grid_blocks = cus * 1;
        if (grid_blocks > NTILES) grid_blocks = NTILES;
        if (ws_size < WS_END) fprintf(stderr, "kernel_launch: workspace too small: %zu < %zu\n", ws_size, (size_t)WS_END);
        fprintf(stderr, "kernel_launch: cus=%d per_cu=%d grid=%d ws=%zu need=%zu\n", cus, per_cu, grid_blocks, ws_size, (size_t)WS_END);
    }
    (void)hipMemsetAsync((unsigned char*)d_ws + WS_BAR, 0, 16384, stream);
    Params p{};
    for (int i = 0; i < 30; ++i) p.in[i] = (const float*)d_in[i];
    p.out = (float*)d_out;
    p.ws = (unsigned char*)d_ws;
    void* args[] = {&p};
    hipError_t e = hipLaunchCooperativeKernel((void*)fwd_kernel, dim3(grid_blocks), dim3(NTHREADS), args, 0, stream);
    if (e != hipSuccess) fprintf(stderr, "cooperative launch failed: %s (grid %d)\n", hipGetErrorString(e), grid_blocks);
}
```
